# Optimizing an MI355X kernel written in HIP

```python
import math
import jax, jax.numpy as jnp
from jax import lax
import numpy as np

D_MODEL = 1024
BATCH = 16
SEQ = 256
DEPTH = 1
DEC_BATCH = 4
DEC_SEQ = 2048
PAST_LEN = 256

GRID_W = 64
N_HEADS = 8
N_KV_HEADS = 2
HEAD_DIM = 128
GROUP = N_HEADS // N_KV_HEADS
ATTN_WIDTH = N_HEADS * HEAD_DIM
KV_WIDTH = N_KV_HEADS * HEAD_DIM
WINDOW = 128
BLOCK = 128
ATTN_SCALE = HEAD_DIM ** -0.5
ROPE_THETA = 10000.0
HYENA_WIDTH = D_MODEL // 2
SHORT_CONV = 3
FILTER_BANDS = 8
FILTER_FEAT = 1 + 2 * FILTER_BANDS
FILTER_HIDDEN = 64
DECAY_TARGET = 1e-2
FAST_DECAY_PCT = 0.3
SLOW_DECAY_PCT = 1.5
D_FF = -(-8 * D_MODEL // (3 * 256)) * 256
IN_WIDTH = ATTN_WIDTH + 2 * KV_WIDTH + 3 * HYENA_WIDTH
EPS = 1e-6
NEG_INF = -1e30

kernel_name = "hybrid_swa_hyena_prefix_diffusion_step"


def rmsnorm(x, g):
    xf = x.astype(jnp.float32)
    y = xf * lax.rsqrt(jnp.mean(xf * xf, axis=-1, keepdims=True) + EPS)
    return (y * g.astype(jnp.float32)).astype(x.dtype)


def modulation(cond, w_mod, b_mod):
    m = jax.nn.silu(cond) @ w_mod + b_mod
    return jnp.split(m[:, None, :], 6, axis=-1)


def axial_rope(x):
    L = x.shape[1]
    rows = L // GRID_W
    row_ids = jnp.repeat(jnp.arange(rows), GRID_W)
    col_ids = jnp.tile(jnp.arange(GRID_W), rows)
    half = HEAD_DIM // 2
    inv_freq = ROPE_THETA ** (-jnp.arange(0, half, 2, dtype=jnp.float32) / half)

    def rot(xa, pos):
        ang = pos.astype(jnp.float32)[:, None] * inv_freq[None, :]
        cos = jnp.cos(ang)[None, :, None, :]
        sin = jnp.sin(ang)[None, :, None, :]
        x1, x2 = jnp.split(xa.astype(jnp.float32), 2, axis=-1)
        return jnp.concatenate([x1 * cos - x2 * sin, x1 * sin + x2 * cos], axis=-1)

    xr, xc = jnp.split(x, 2, axis=-1)
    return jnp.concatenate([rot(xr, row_ids), rot(xc, col_ids)], axis=-1).astype(x.dtype)


def context_attention(q, k, v, sink):
    B, L = q.shape[:2]
    qg = q.reshape(B, L, N_KV_HEADS, GROUP, HEAD_DIM)
    s = jnp.einsum('bqkgd,bckd->bkgqc', qg, k).astype(jnp.float32) * ATTN_SCALE
    sink_b = jnp.broadcast_to(sink.astype(jnp.float32).reshape(1, N_KV_HEADS, GROUP, 1, 1), s.shape[:-1] + (1,))
    p = jax.nn.softmax(jnp.concatenate([s, sink_b], axis=-1), axis=-1)[..., :-1]
    o = jnp.einsum('bkgqc,bckd->bqkgd', p.astype(v.dtype), v)
    return o.reshape(B, L, ATTN_WIDTH)


def latent_attention(q, k, v, ctx_k, ctx_v, sink):
    B, L = q.shape[:2]
    nb = L // BLOCK
    qb = q.reshape(B, nb, BLOCK, N_KV_HEADS, GROUP, HEAD_DIM)
    pad = ((0, 0), (BLOCK, BLOCK), (0, 0), (0, 0))
    kp = jnp.pad(k, pad).reshape(B, nb + 2, BLOCK, N_KV_HEADS, HEAD_DIM)
    vp = jnp.pad(v, pad).reshape(B, nb + 2, BLOCK, N_KV_HEADS, HEAD_DIM)
    kwin = jnp.concatenate([kp[:, :-2], kp[:, 1:-1], kp[:, 2:]], axis=2)
    vwin = jnp.concatenate([vp[:, :-2], vp[:, 1:-1], vp[:, 2:]], axis=2)
    blk = jnp.arange(nb)[:, None]
    qpos = blk * BLOCK + jnp.arange(BLOCK)[None, :]
    kpos = (blk - 1) * BLOCK + jnp.arange(3 * BLOCK)[None, :]
    rel = kpos[:, None, :] - qpos[:, :, None]
    valid = (jnp.abs(rel) <= WINDOW) & (kpos[:, None, :] >= 0) & (kpos[:, None, :] < L)
    s_win = jnp.einsum('bnqkgd,bnskd->bnkgqs', qb, kwin).astype(jnp.float32) * ATTN_SCALE
    s_win = jnp.where(valid[None, :, None, None], s_win, NEG_INF)
    s_ctx = jnp.einsum('bnqkgd,bckd->bnkgqc', qb, ctx_k).astype(jnp.float32) * ATTN_SCALE
    sink_b = jnp.broadcast_to(sink.astype(jnp.float32).reshape(1, 1, N_KV_HEADS, GROUP, 1, 1), s_win.shape[:-1] + (1,))
    p = jax.nn.softmax(jnp.concatenate([s_win, s_ctx, sink_b], axis=-1), axis=-1)
    p_win = p[..., :3 * BLOCK].astype(v.dtype)
    p_ctx = p[..., 3 * BLOCK:-1].astype(v.dtype)
    o = (jnp.einsum('bnkgqs,bnskd->bnqkgd', p_win, vwin)
         + jnp.einsum('bnkgqc,bckd->bnqkgd', p_ctx, ctx_v))
    return o.reshape(B, L, ATTN_WIDTH)


def hyena_filter_spectrum(L, w1, b1, fr1, w2, b2, fr2, w3, b3, decay):
    f32 = jnp.float32
    t = jnp.arange(L, dtype=f32)
    t_norm = t / L
    bands = jnp.linspace(1e-4, FILTER_BANDS - 1, FILTER_BANDS).astype(f32)
    ang = (2.0 * math.pi * t / L)[:, None] * bands[None, :]
    feat = jnp.concatenate([t_norm[:, None], jnp.cos(ang), jnp.sin(ang)], axis=-1)
    h = jnp.sin(fr1.astype(f32) * (feat @ w1.astype(f32) + b1.astype(f32)))
    h = jnp.sin(fr2.astype(f32) * (h @ w2.astype(f32) + b2.astype(f32)))
    h = h @ w3.astype(f32) + b3.astype(f32)
    h = h * jnp.exp(-t_norm[:, None] * jnp.abs(decay.astype(f32))[None, :])
    fwd, bwd = jnp.split(h, 2, axis=-1)
    filt = jnp.concatenate([fwd, jnp.zeros((1, HYENA_WIDTH), f32), bwd[:0:-1]], axis=0)
    return jnp.fft.rfft(filt, axis=0)


def short_conv(u, w, b):
    up = jnp.pad(u, ((0, 0), (1, 1), (0, 0)))
    return up[:, :-2] * w[0] + up[:, 1:-1] * w[1] + up[:, 2:] * w[2] + b


def hyena(u, conv_w, conv_b, spectrum, skip):
    L = u.shape[1]
    u = short_conv(u, conv_w, conv_b)
    x0, x1, v = jnp.split(u, 3, axis=-1)
    z = (v * x1).astype(jnp.float32)
    zf = jnp.fft.rfft(z, n=2 * L, axis=1)
    y = jnp.fft.irfft(zf * spectrum[None], n=2 * L, axis=1)[:, :L] + z * skip.astype(jnp.float32)
    return (x0.astype(jnp.float32) * y).astype(u.dtype)


def mixer(h, p, latent, ctx_k, ctx_v):
    B, L = h.shape[:2]
    proj = h @ p['w_in']
    q, k, v, hy = jnp.split(proj, [ATTN_WIDTH, ATTN_WIDTH + KV_WIDTH, ATTN_WIDTH + 2 * KV_WIDTH], axis=-1)
    q = q.reshape(B, L, N_HEADS, HEAD_DIM)
    k = k.reshape(B, L, N_KV_HEADS, HEAD_DIM)
    v = v.reshape(B, L, N_KV_HEADS, HEAD_DIM)
    if latent:
        attn = latent_attention(axial_rope(q), axial_rope(k), v, ctx_k, ctx_v, p['attn_sink'])
    else:
        attn = context_attention(q, k, v, p['attn_sink'])
    spectrum = hyena_filter_spectrum(L, p['filt_w1'], p['filt_b1'], p['filt_freq1'], p['filt_w2'], p['filt_b2'],
                                     p['filt_freq2'], p['filt_w3'], p['filt_b3'], p['filt_decay'])
    hy_out = hyena(hy, p['conv_w'], p['conv_b'], spectrum, p['hyena_skip'])
    gates = jax.nn.sigmoid((h @ p['w_gate'] + p['b_gate']).astype(jnp.float32)).astype(h.dtype)
    g_a, g_h = jnp.split(gates, 2, axis=-1)
    merged = g_a * (attn @ p['w_pa']) + g_h * (hy_out @ p['w_ph'])
    return merged @ p['w_o'], k, v


def layer(x, cond, p, latent, ctx_k, ctx_v):
    sh1, sc1, g1, sh2, sc2, g2 = modulation(cond, p['w_mod'], p['b_mod'])
    h = rmsnorm(x, p['norm_mix_pre']) * (1 + sc1) + sh1
    mix, k, v = mixer(h, p, latent, ctx_k, ctx_v)
    x = x + g1 * rmsnorm(mix, p['norm_mix_post'])
    h = rmsnorm(x, p['norm_ffn_pre']) * (1 + sc2) + sh2
    gt, up = jnp.split(h @ p['w_up'], 2, axis=-1)
    f = (jax.nn.silu(gt) * up) @ p['w_down']
    x = x + g2 * rmsnorm(f, p['norm_ffn_post'])
    return x, k, v


def setup_inputs(seed: int = 0) -> dict:
    key = jax.random.key(seed)
    ks = iter(jax.random.split(key, 40))
    nrm = lambda shape, s=1.0: jax.random.normal(next(ks), shape, jnp.float32) * s
    D = D_MODEL
    max_decay = abs(math.log(DECAY_TARGET)) / FAST_DECAY_PCT
    min_decay = abs(math.log(DECAY_TARGET)) / SLOW_DECAY_PCT
    return {
        'x_prompt': nrm((BATCH, SEQ, D)),
        'x_sample': nrm((DEC_BATCH, DEC_SEQ, D)),
        'c': nrm((DEC_BATCH, D)),
        'cache_k': nrm((DEC_BATCH, DEPTH, PAST_LEN, N_KV_HEADS, HEAD_DIM)),
        'cache_v': nrm((DEC_BATCH, DEPTH, PAST_LEN, N_KV_HEADS, HEAD_DIM)),
        'c_ctx': nrm((D,)),
        'norm_mix_pre': 1.0 + nrm((DEPTH, D), 0.1),
        'norm_mix_post': 1.0 + nrm((DEPTH, D), 0.1),
        'norm_ffn_pre': 1.0 + nrm((DEPTH, D), 0.1),
        'norm_ffn_post': 1.0 + nrm((DEPTH, D), 0.1),
        'w_mod': nrm((DEPTH, D, 6 * D), 0.5 * D ** -0.5),
        'b_mod': nrm((DEPTH, 6 * D), 0.01),
        'w_in': nrm((DEPTH, D, IN_WIDTH), D ** -0.5),
        'attn_sink': nrm((DEPTH, N_HEADS)),
        'conv_w': nrm((DEPTH, SHORT_CONV, 3 * HYENA_WIDTH), 0.5),
        'conv_b': nrm((DEPTH, 3 * HYENA_WIDTH), 0.01),
        'filt_w1': nrm((DEPTH, FILTER_FEAT, FILTER_HIDDEN), FILTER_FEAT ** -0.5),
        'filt_b1': nrm((DEPTH, FILTER_HIDDEN), 0.1),
        'filt_freq1': 1.0 + nrm((DEPTH, FILTER_HIDDEN), 0.1),
        'filt_w2': nrm((DEPTH, FILTER_HIDDEN, FILTER_HIDDEN), FILTER_HIDDEN ** -0.5),
        'filt_b2': nrm((DEPTH, FILTER_HIDDEN), 0.1),
        'filt_freq2': 1.0 + nrm((DEPTH, FILTER_HIDDEN), 0.1),
        'filt_w3': nrm((DEPTH, FILTER_HIDDEN, 2 * HYENA_WIDTH), FILTER_HIDDEN ** -0.5),
        'filt_b3': nrm((DEPTH, 2 * HYENA_WIDTH), 0.01),
        'filt_decay': jax.random.uniform(next(ks), (DEPTH, 2 * HYENA_WIDTH), jnp.float32, min_decay, max_decay),
        'hyena_skip': nrm((DEPTH, HYENA_WIDTH), 0.5),
        'w_pa': nrm((DEPTH, ATTN_WIDTH, D), ATTN_WIDTH ** -0.5),
        'w_ph': nrm((DEPTH, HYENA_WIDTH, D), HYENA_WIDTH ** -0.5),
        'w_gate': nrm((DEPTH, D, 2 * D), D ** -0.5),
        'b_gate': nrm((DEPTH, 2 * D), 0.01),
        'w_o': nrm((DEPTH, D, D), D ** -0.5),
        'w_up': nrm((DEPTH, D, 2 * D_FF), D ** -0.5),
        'w_down': nrm((DEPTH, D_FF, D), D_FF ** -0.5),
    }


def reference(x_prompt, x_sample, c, cache_k, cache_v, c_ctx,
              norm_mix_pre, norm_mix_post, norm_ffn_pre, norm_ffn_post, w_mod, b_mod,
              w_in, attn_sink, conv_w, conv_b, filt_w1, filt_b1, filt_freq1, filt_w2, filt_b2,
              filt_freq2, filt_w3, filt_b3, filt_decay, hyena_skip, w_pa, w_ph, w_gate, b_gate,
              w_o, w_up, w_down):
    y_prompt = x_prompt
    y_sample = x_sample
    new_k_layers = []
    new_v_layers = []
    for l in range(DEPTH):
        p = {
            'norm_mix_pre': norm_mix_pre[l], 'norm_mix_post': norm_mix_post[l],
            'norm_ffn_pre': norm_ffn_pre[l], 'norm_ffn_post': norm_ffn_post[l],
            'w_mod': w_mod[l], 'b_mod': b_mod[l], 'w_in': w_in[l], 'attn_sink': attn_sink[l],
            'conv_w': conv_w[l], 'conv_b': conv_b[l],
            'filt_w1': filt_w1[l], 'filt_b1': filt_b1[l], 'filt_freq1': filt_freq1[l],
            'filt_w2': filt_w2[l], 'filt_b2': filt_b2[l], 'filt_freq2': filt_freq2[l],
            'filt_w3': filt_w3[l], 'filt_b3': filt_b3[l], 'filt_decay': filt_decay[l],
            'hyena_skip': hyena_skip[l], 'w_pa': w_pa[l], 'w_ph': w_ph[l],
            'w_gate': w_gate[l], 'b_gate': b_gate[l], 'w_o': w_o[l],
            'w_up': w_up[l], 'w_down': w_down[l],
        }
        y_prompt, k_ctx, v_ctx = layer(y_prompt, c_ctx[None, :], p, False, None, None)
        new_k_layers.append(k_ctx)
        new_v_layers.append(v_ctx)
        y_sample, _, _ = layer(y_sample, c, p, True, cache_k[:, l], cache_v[:, l])
    new_k = jnp.stack(new_k_layers, axis=1)
    new_v = jnp.stack(new_v_layers, axis=1)
    return (y_prompt, y_sample, new_k, new_v)
```

```cpp
#include <hip/hip_runtime.h>
#include <cstdio>
#include <cstdint>
__device__ __forceinline__ int lane_id() { int l; asm volatile("v_mbcnt_lo_u32_b32 %0, -1, 0\n\tv_mbcnt_hi_u32_b32 %0, -1, %0" : "=v"(l)); return l; }
namespace pg8 {
#define PG8_LAS __attribute__((address_space(3)))
typedef unsigned short bf16_t;
typedef short bf16x8 __attribute__((ext_vector_type(8)));
typedef float f32x4 __attribute__((ext_vector_type(4)));
typedef unsigned u32x4 __attribute__((ext_vector_type(4)));
constexpr int BM = 256, BK = 64, HALF = 128, HTB = HALF * BK * 2  , STAGE_BYTES = 8 * HTB, NXCD = 8, WGM = 8;

__host__ __device__ __forceinline__ int lds_byte(int r, int c) { const int st = (r >> 4) * 2 + (c >> 5), rr = r & 15, cc = c & 31, ob = rr * 64 + cc * 2; return st * 1024 + (ob ^ (((ob >> 9) & 1) << 5)); }
__host__ __device__ __forceinline__ void stage_rc(int b, int& R, int& C) { const int st = b / 1024, sb = b % 1024, swz = sb ^ (((sb >> 9) & 1) << 5); R = (st >> 1) * 16 + swz / 64; C = (st & 1) * 32 + (swz % 64) / 2; }
__host__ __device__ __forceinline__ int perm32(int rho) { const int n = rho >> 4, i = rho & 15; return 8 * (i >> 2) + 4 * n + (i & 3); }

struct Unit { int pm, pn; };
struct Gemm { const bf16_t* A; const bf16_t* Bt; int M, N, K; };

struct StaticOrder {
    int nM, nN, nwg, G, c;
    __host__ __device__ void init(int M, int N, int G_, int c_) { nM = M / BM; nN = N / BM; nwg = nM * nN; G = G_; c = c_; }
    __host__ __device__ bool next(int i, Unit& u) const {
        const long L = (long)i * G + c; if (L >= nwg) return false;
        int wgid = (int)L; { const int q = nwg / NXCD, r = nwg % NXCD, xcd = wgid % NXCD, off = wgid / NXCD; wgid = (xcd < r ? xcd * (q + 1) : r * (q + 1) + (xcd - r) * q) + off; }
        const int nig = WGM * nN, gid = wgid / nig, fm = gid * WGM, gsz = (nM - fm) < WGM ? (nM - fm) : WGM;
        u.pm = fm + ((wgid % nig) % gsz); u.pn = (wgid % nig) / gsz; return true;
    }
    __device__ __forceinline__ void a_ready(const Unit&) const {}
    __device__ __forceinline__ void done(const Unit&) const {}
};


__device__ __forceinline__ unsigned cvt_pk_bf16(float lo, float hi) { unsigned r; asm volatile("v_cvt_pk_bf16_f32 %0, %1, %2" : "=v"(r) : "v"(lo), "v"(hi)); return r; }
typedef float f32x2 __attribute__((ext_vector_type(2)));
typedef unsigned u32x2 __attribute__((ext_vector_type(2)));
__device__ __forceinline__ float bf_lo(unsigned w) { return __uint_as_float(w << 16); }
__device__ __forceinline__ float bf_hi(unsigned w) { return __uint_as_float(w & 0xffff0000u); }
__device__ __forceinline__ float sigmoid_f(float x) { return __builtin_amdgcn_rcpf(1.0f + __builtin_amdgcn_exp2f(-1.4426950408889634f * x)); }

constexpr int M_CTX = 4096;
constexpr float QSCALE = 0.088388347648318440f * 1.4426950408889634f;

struct EpiF32 {
    static constexpr bool PERM = false, AFTER_DRAIN = false; static constexpr int MID_T = -1;
    float* C; int ldc;
    __device__ __forceinline__ void mid(f32x4 (&acc)[2][2][4][2], const Unit& u, int wr, int wc, int fr, int fq) const {}
    __device__ __forceinline__ void operator()(const f32x4 (&acc)[2][2][4][2], const Unit& u, int wr, int wc, int fr, int fq) const {
        const int row0 = u.pm * BM + wr * 64 + fr, col0 = u.pn * BM + wc * 32 + 4 * fq;
#pragma unroll
        for (int ai = 0; ai < 2; ++ai)
#pragma unroll
            for (int m = 0; m < 4; ++m) { float* rowp = C + (size_t)(row0 + ai * HALF + m * 16) * ldc + col0;
#pragma unroll
                for (int bj = 0; bj < 2; ++bj)
#pragma unroll
                    for (int n = 0; n < 2; ++n) *(f32x4*)(rowp + bj * HALF + n * 16) = acc[ai][bj][m][n]; }
    }
};

struct EpiIn {
    static constexpr bool PERM = true, AFTER_DRAIN = false; static constexpr int MID_T = -1;
    bf16_t *Q, *Kb, *Vb, *HY, *GT; float *newk, *newv; const float* bgate; const float* rope;
    __device__ __forceinline__ void mid(f32x4 (&acc)[2][2][4][2], const Unit& u, int wr, int wc, int fr, int fq) const {}
    __device__ __forceinline__ void operator()(const f32x4 (&acc)[2][2][4][2], const Unit& u, int wr, int wc, int fr, int fq) const {
        const int pn = u.pn, rowb = u.pm * BM + wr * 64 + fr;
        const bool latent = u.pm >= (M_CTX / BM);
        if (pn < 5) {
            const int fidx = ((wc & 1) * 4 + fq) * 4, d0 = (wc >> 1) * 64 + fidx;
            const bool isq = pn < 4; const float sc = isq ? QSCALE : 1.0f;
#pragma unroll
            for (int ai = 0; ai < 2; ++ai)
#pragma unroll
                for (int m = 0; m < 4; ++m) {
                    const int row = rowb + ai * HALF + m * 16;
                    f32x4 cs0 = (f32x4){1.f, 0.f, 1.f, 0.f}, cs1 = cs0;
                    if (latent) { const int t = (row - M_CTX) & 2047, pos = (wc >> 1) ? (t & 63) : (t >> 6);
                        const f32x4* rp = (const f32x4*)(rope + (size_t)(pos * 32 + fidx) * 2); cs0 = rp[0]; cs1 = rp[1]; }
#pragma unroll
                    for (int bj = 0; bj < 2; ++bj) {
                        const f32x4 x1 = acc[ai][bj][m][0], x2 = acc[ai][bj][m][1];
                        f32x4 o1, o2;
                        o1[0] = (x1[0] * cs0[0] - x2[0] * cs0[1]) * sc; o2[0] = (x1[0] * cs0[1] + x2[0] * cs0[0]) * sc;
                        o1[1] = (x1[1] * cs0[2] - x2[1] * cs0[3]) * sc; o2[1] = (x1[1] * cs0[3] + x2[1] * cs0[2]) * sc;
                        o1[2] = (x1[2] * cs1[0] - x2[2] * cs1[1]) * sc; o2[2] = (x1[2] * cs1[1] + x2[2] * cs1[0]) * sc;
                        o1[3] = (x1[3] * cs1[2] - x2[3] * cs1[3]) * sc; o2[3] = (x1[3] * cs1[3] + x2[3] * cs1[2]) * sc;
                        u32x2 w1, w2; w1.x = cvt_pk_bf16(o1[0], o1[1]); w1.y = cvt_pk_bf16(o1[2], o1[3]); w2.x = cvt_pk_bf16(o2[0], o2[1]); w2.y = cvt_pk_bf16(o2[2], o2[3]);
                        if (isq) { bf16_t* p = Q + (size_t)row * 1024 + (pn * 2 + bj) * 128 + d0; *(u32x2*)p = w1; *(u32x2*)(p + 32) = w2; }
                        else { bf16_t* p = Kb + (size_t)row * 256 + bj * 128 + d0; *(u32x2*)p = w1; *(u32x2*)(p + 32) = w2;
                            if (!latent) { float* q = newk + (size_t)row * 256 + bj * 128 + d0; *(f32x4*)q = o1; *(f32x4*)(q + 32) = o2; } }
                    }
                }
        } else {
            const int cin = wc * 32 + 8 * fq;
            bf16_t* base; int ld, col0;
            if (pn == 5) { base = Vb; ld = 256; col0 = 0; } else if (pn < 12) { base = HY; ld = 1536; col0 = (pn - 6) * BM; } else { base = GT; ld = 2048; col0 = (pn - 12) * BM; }
            f32x4 bv[2][2];
#pragma unroll
            for (int bj = 0; bj < 2; ++bj)
#pragma unroll
                for (int n = 0; n < 2; ++n) bv[bj][n] = (pn >= 12) ? *(const f32x4*)(bgate + col0 + bj * HALF + cin + 4 * n) : (f32x4){0.f, 0.f, 0.f, 0.f};
#pragma unroll
            for (int ai = 0; ai < 2; ++ai)
#pragma unroll
                for (int m = 0; m < 4; ++m) {
                    const int row = rowb + ai * HALF + m * 16;
#pragma unroll
                    for (int bj = 0; bj < 2; ++bj) {
                        f32x4 v0 = acc[ai][bj][m][0] + bv[bj][0], v1 = acc[ai][bj][m][1] + bv[bj][1];
                        if (pn >= 12) {
#pragma unroll
                            for (int j = 0; j < 4; ++j) { v0[j] = sigmoid_f(v0[j]); v1[j] = sigmoid_f(v1[j]); } }
                        u32x4 w; w.x = cvt_pk_bf16(v0[0], v0[1]); w.y = cvt_pk_bf16(v0[2], v0[3]); w.z = cvt_pk_bf16(v1[0], v1[1]); w.w = cvt_pk_bf16(v1[2], v1[3]);
                        *(u32x4*)(base + (size_t)row * ld + col0 + bj * HALF + cin) = w;
                        if (pn == 5 && !latent) { float* q = newv + (size_t)row * 256 + bj * HALF + cin; *(f32x4*)q = v0; *(f32x4*)(q + 4) = v1; }
                    }
                }
        }
    }
};

struct EpiMerge {
    static constexpr bool PERM = true, AFTER_DRAIN = false; static constexpr int MID_T = 16;
    const bf16_t* GT; bf16_t* MG;
    __device__ __forceinline__ void mid(f32x4 (&acc)[2][2][4][2], const Unit& u, int wr, int wc, int fr, int fq) const {
        const int rowb = u.pm * BM + wr * 64 + fr, colb = u.pn * BM + wc * 32 + 8 * fq;
#pragma unroll
        for (int ai = 0; ai < 2; ++ai)
#pragma unroll
            for (int m = 0; m < 4; ++m) {
                const bf16_t* g = GT + (size_t)(rowb + ai * HALF + m * 16) * 2048 + colb;
#pragma unroll
                for (int bj = 0; bj < 2; ++bj) {
                    const u32x4 ga = *(const u32x4*)(g + bj * HALF), gh = *(const u32x4*)(g + 1024 + bj * HALF);
                    f32x4& a0 = acc[ai][bj][m][0]; f32x4& a1 = acc[ai][bj][m][1];
                    a0[0] *= bf_lo(ga.x) * __builtin_amdgcn_rcpf(bf_lo(gh.x)); a0[1] *= bf_hi(ga.x) * __builtin_amdgcn_rcpf(bf_hi(gh.x));
                    a0[2] *= bf_lo(ga.y) * __builtin_amdgcn_rcpf(bf_lo(gh.y)); a0[3] *= bf_hi(ga.y) * __builtin_amdgcn_rcpf(bf_hi(gh.y));
                    a1[0] *= bf_lo(ga.z) * __builtin_amdgcn_rcpf(bf_lo(gh.z)); a1[1] *= bf_hi(ga.z) * __builtin_amdgcn_rcpf(bf_hi(gh.z));
                    a1[2] *= bf_lo(ga.w) * __builtin_amdgcn_rcpf(bf_lo(gh.w)); a1[3] *= bf_hi(ga.w) * __builtin_amdgcn_rcpf(bf_hi(gh.w));
                }
            }
    }
    __device__ __forceinline__ void operator()(const f32x4 (&acc)[2][2][4][2], const Unit& u, int wr, int wc, int fr, int fq) const {
        const int rowb = u.pm * BM + wr * 64 + fr, colb = u.pn * BM + wc * 32 + 8 * fq;
#pragma unroll
        for (int ai = 0; ai < 2; ++ai)
#pragma unroll
            for (int m = 0; m < 4; ++m) {
                const size_t ro = (size_t)(rowb + ai * HALF + m * 16);
#pragma unroll
                for (int bj = 0; bj < 2; ++bj) {
                    const u32x4 gh = *(const u32x4*)(GT + ro * 2048 + 1024 + colb + bj * HALF);
                    const f32x4 a0 = acc[ai][bj][m][0], a1 = acc[ai][bj][m][1];
                    u32x4 w; w.x = cvt_pk_bf16(a0[0] * bf_lo(gh.x), a0[1] * bf_hi(gh.x)); w.y = cvt_pk_bf16(a0[2] * bf_lo(gh.y), a0[3] * bf_hi(gh.y));
                    w.z = cvt_pk_bf16(a1[0] * bf_lo(gh.z), a1[1] * bf_hi(gh.z)); w.w = cvt_pk_bf16(a1[2] * bf_lo(gh.w), a1[3] * bf_hi(gh.w));
                    *(u32x4*)(MG + ro * 1024 + colb + bj * HALF) = w;
                }
            }
    }
};

struct EpiSwiGLU {
    static constexpr bool PERM = true, AFTER_DRAIN = false; static constexpr int MID_T = -1;
    bf16_t* ACT; int ld;
    __device__ __forceinline__ void mid(f32x4 (&acc)[2][2][4][2], const Unit& u, int wr, int wc, int fr, int fq) const {}
    __device__ __forceinline__ void operator()(const f32x4 (&acc)[2][2][4][2], const Unit& u, int wr, int wc, int fr, int fq) const {
        const int rowb = u.pm * BM + wr * 64 + fr, colb = u.pn * HALF + wc * 32 + 8 * fq;
#pragma unroll
        for (int ai = 0; ai < 2; ++ai)
#pragma unroll
            for (int m = 0; m < 4; ++m) {
                float o[8];
#pragma unroll
                for (int n = 0; n < 2; ++n)
#pragma unroll
                    for (int j = 0; j < 4; ++j) { const float g = acc[ai][0][m][n][j], up = acc[ai][1][m][n][j]; o[n * 4 + j] = g * sigmoid_f(g) * up; }
                u32x4 w; w.x = cvt_pk_bf16(o[0], o[1]); w.y = cvt_pk_bf16(o[2], o[3]); w.z = cvt_pk_bf16(o[4], o[5]); w.w = cvt_pk_bf16(o[6], o[7]);
                *(u32x4*)(ACT + (size_t)(rowb + ai * HALF + m * 16) * ld + colb) = w;
            }
    }
};

template <class Epi, class Sched, bool ALIGN_EPI = false, bool SP2 = false>
__device__ __forceinline__ void gemm_phase(PG8_LAS unsigned char* lds, const Gemm g, const Sched& S, const Epi& E, const int wid) {
    const int lane = lane_id(), tid = wid * 64 + lane, wr = wid >> 2, wc = wid & 3, fr = lane & 15, fq = lane >> 4;
    const int K = g.K, nt = K / BK;
    unsigned voffA[2], voffB[2];
#pragma unroll
    for (int i = 0; i < 2; ++i) { int R, C; stage_rc(tid * 16 + i * 8192, R, C); const int Rb = Epi::PERM ? ((R & ~31) + perm32(R & 31)) : R;
        voffA[i] = (unsigned)(R * K + C) * 2u; voffB[i] = (unsigned)(Rb * K + C) * 2u; }
    const size_t kstep = (size_t)(BK * 2);
    const size_t hstep = (size_t)HALF * K * 2;
    const size_t tstep = 2 * hstep;
    const unsigned ldsw = (unsigned)wid * 1024u;
    const int aoff = lds_byte(wr * 64 + fr, fq * 8), boff = lds_byte(wc * 32 + fr, fq * 8);
#define PG8_SA(b, h) (((b) * 2 + (h)) * HTB)
#define PG8_SB(b, h) ((4 + (b) * 2 + (h)) * HTB)
#define PG8_STAGE(bufoff, gbase, voff) do { _Pragma("unroll") for (int _i = 0; _i < 2; ++_i) \
        __builtin_amdgcn_global_load_lds((const unsigned*)((const char*)(gbase) + (voff)[_i]), (PG8_LAS unsigned*)(lds + (bufoff) + ldsw + _i * 8192), 16, 0, 0); } while (0)
#define PG8_LDA(dst, b, h) do { _Pragma("unroll") for (int m = 0; m < 4; ++m) _Pragma("unroll") for (int k = 0; k < 2; ++k) dst[m][k] = *(const PG8_LAS bf16x8*)(lds + PG8_SA(b, h) + aoff + m * 2048 + k * 1024); } while (0)
#define PG8_LDB(dst, b, h) do { _Pragma("unroll") for (int n = 0; n < 2; ++n) _Pragma("unroll") for (int k = 0; k < 2; ++k) dst[n][k] = *(const PG8_LAS bf16x8*)(lds + PG8_SB(b, h) + boff + n * 2048 + k * 1024); } while (0)
#define PG8_MMA(ai, bj, At, Bt) do { __builtin_amdgcn_s_setprio(1); _Pragma("unroll") for (int m = 0; m < 4; ++m) _Pragma("unroll") for (int n = 0; n < 2; ++n) _Pragma("unroll") for (int k = 0; k < 2; ++k) \
        acc[ai][bj][m][n] = __builtin_amdgcn_mfma_f32_16x16x32_bf16(Bt[n][k], At[m][k], acc[ai][bj][m][n], 0, 0, 0); __builtin_amdgcn_s_setprio(0); } while (0)
#define PG8_WAIT_V(n) asm volatile("s_waitcnt vmcnt(" #n ")" ::: "memory")
#define PG8_WAIT_L(n) asm volatile("s_waitcnt lgkmcnt(" #n ")" ::: "memory")
#define PG8_BAR __builtin_amdgcn_s_barrier()
#define PG8_SCHED __builtin_amdgcn_sched_barrier(0)
    Unit cur, nxt; int ui = 0;
    if (!S.next(0, cur)) return;
    f32x4 acc[2][2][4][2];
#pragma unroll
    for (int a = 0; a < 2; ++a)
#pragma unroll
        for (int b = 0; b < 2; ++b)
#pragma unroll
            for (int m = 0; m < 4; ++m)
#pragma unroll
                for (int n = 0; n < 2; ++n) acc[a][b][m][n] = (f32x4){0.f, 0.f, 0.f, 0.f};
    bf16x8 At[4][2], B0[2][2], B1[2][2];
    const char* cA = (const char*)g.A + (size_t)cur.pm * tstep; const char* cB = (const char*)g.Bt + (size_t)cur.pn * tstep;
    S.a_ready(cur);
    if constexpr (SP2) {
        PG8_STAGE(PG8_SB(0, 0), cB, voffB); PG8_STAGE(PG8_SB(0, 1), cB + hstep, voffB); PG8_STAGE(PG8_SA(0, 0), cA, voffA); PG8_STAGE(PG8_SA(0, 1), cA + hstep, voffA);
        if (wr == 1) PG8_BAR;
        PG8_WAIT_V(2); PG8_BAR;
        PG8_STAGE(PG8_SB(1, 0), cB + kstep, voffB); PG8_STAGE(PG8_SA(1, 0), cA + kstep, voffA); PG8_STAGE(PG8_SB(1, 1), cB + hstep + kstep, voffB);
        PG8_WAIT_V(6); PG8_BAR;
    } else {
        PG8_STAGE(PG8_SB(0, 0), cB, voffB); PG8_STAGE(PG8_SA(0, 0), cA, voffA); PG8_STAGE(PG8_SB(0, 1), cB + hstep, voffB); PG8_STAGE(PG8_SA(0, 1), cA + hstep, voffA);
        if (wr == 1) PG8_BAR;
        PG8_WAIT_V(4); PG8_BAR;
        PG8_STAGE(PG8_SB(1, 0), cB + kstep, voffB); PG8_STAGE(PG8_SA(1, 0), cA + kstep, voffA); PG8_STAGE(PG8_SB(1, 1), cB + hstep + kstep, voffB);
        PG8_WAIT_V(6); PG8_BAR;
    }
    for (;;) {
        const bool has_next = S.next(ui + 1, nxt);
        const char* nA = has_next ? (const char*)g.A + (size_t)nxt.pm * tstep : cA; const char* nB = has_next ? (const char*)g.Bt + (size_t)nxt.pn * tstep : cB;
        for (int t = 0; t < nt; t += 2) {
            if constexpr (Epi::MID_T >= 0) { if (t == Epi::MID_T) E.mid(acc, cur, wr, wc, fr, fq); }
            const bool last = (t == nt - 2);
            const char* a1 = cA + (size_t)(t + 1) * kstep;
            const char* a2 = last ? nA : cA + (size_t)(t + 2) * kstep; const char* b2 = last ? nB : cB + (size_t)(t + 2) * kstep;
            const char* a3 = a2 + kstep; const char* b3 = b2 + kstep;
            if (last && has_next) S.a_ready(nxt);
            if constexpr (SP2) {
            PG8_LDB(B0, 0, 0); PG8_LDB(B1, 0, 1); PG8_SCHED; PG8_LDA(At, 0, 0); PG8_STAGE(PG8_SA(1, 1), a1 + hstep, voffA);
            PG8_WAIT_V(8); PG8_WAIT_L(0); PG8_BAR; PG8_MMA(0, 0, At, B0); PG8_MMA(0, 1, At, B1); PG8_BAR; PG8_SCHED;
            PG8_LDA(At, 0, 1); PG8_STAGE(PG8_SB(0, 0), b2, voffB); PG8_STAGE(PG8_SB(0, 1), b2 + hstep, voffB); PG8_STAGE(PG8_SA(0, 0), a2, voffA);
            PG8_WAIT_V(8); PG8_WAIT_L(0); PG8_BAR; PG8_MMA(1, 0, At, B0); PG8_MMA(1, 1, At, B1); PG8_BAR; PG8_SCHED;
            PG8_LDB(B0, 1, 0); PG8_LDB(B1, 1, 1); PG8_SCHED; PG8_LDA(At, 1, 0); PG8_STAGE(PG8_SA(0, 1), a2 + hstep, voffA);
            PG8_WAIT_V(8); PG8_WAIT_L(0); PG8_BAR; PG8_MMA(0, 0, At, B0); PG8_MMA(0, 1, At, B1); PG8_BAR; PG8_SCHED;
            PG8_LDA(At, 1, 1); PG8_STAGE(PG8_SB(1, 0), b3, voffB); PG8_STAGE(PG8_SB(1, 1), b3 + hstep, voffB); PG8_STAGE(PG8_SA(1, 0), a3, voffA);
            PG8_WAIT_V(8); PG8_WAIT_L(0); PG8_BAR; PG8_MMA(1, 0, At, B0); PG8_MMA(1, 1, At, B1); PG8_BAR; PG8_SCHED;
            } else {
            PG8_LDB(B0, 0, 0); PG8_SCHED; PG8_LDA(At, 0, 0); PG8_STAGE(PG8_SA(1, 1), a1 + hstep, voffA);
            PG8_WAIT_L(8); PG8_BAR; PG8_WAIT_L(0); PG8_MMA(0, 0, At, B0); PG8_BAR; PG8_SCHED;
            PG8_LDB(B1, 0, 1); PG8_STAGE(PG8_SB(0, 0), b2, voffB);
            PG8_BAR; PG8_WAIT_L(0); PG8_MMA(0, 1, At, B1); PG8_BAR;
            PG8_LDA(At, 0, 1); PG8_STAGE(PG8_SA(0, 0), a2, voffA);
            PG8_BAR; PG8_WAIT_L(0); PG8_MMA(1, 0, At, B0); PG8_BAR; PG8_SCHED;
            PG8_STAGE(PG8_SB(0, 1), b2 + hstep, voffB);
            PG8_WAIT_V(6); PG8_BAR; PG8_MMA(1, 1, At, B1); PG8_BAR;
            PG8_LDB(B0, 1, 0); PG8_SCHED; PG8_LDA(At, 1, 0); PG8_STAGE(PG8_SA(0, 1), a2 + hstep, voffA);
            PG8_WAIT_L(8); PG8_BAR; PG8_WAIT_L(0); PG8_MMA(0, 0, At, B0); PG8_BAR; PG8_SCHED;
            PG8_LDB(B1, 1, 1); PG8_STAGE(PG8_SB(1, 0), b3, voffB);
            PG8_BAR; PG8_WAIT_L(0); PG8_MMA(0, 1, At, B1); PG8_BAR;
            PG8_LDA(At, 1, 1); PG8_STAGE(PG8_SA(1, 0), a3, voffA);
            PG8_BAR; PG8_WAIT_L(0); PG8_MMA(1, 0, At, B0); PG8_BAR; PG8_SCHED;
            PG8_STAGE(PG8_SB(1, 1), b3 + hstep, voffB);
            PG8_WAIT_V(6); PG8_BAR; PG8_MMA(1, 1, At, B1); PG8_BAR;
            }
        }
        if constexpr (ALIGN_EPI) { if (wr == 0) PG8_BAR; }
        if constexpr (!Epi::AFTER_DRAIN) { E(acc, cur, wr, wc, fr, fq); S.done(cur); }
        if (!has_next) break;
#pragma unroll
        for (int a = 0; a < 2; ++a)
#pragma unroll
            for (int b = 0; b < 2; ++b)
#pragma unroll
                for (int m = 0; m < 4; ++m)
#pragma unroll
                    for (int n = 0; n < 2; ++n) acc[a][b][m][n] = (f32x4){0.f, 0.f, 0.f, 0.f};
        cur = nxt; cA = nA; cB = nB; ++ui;
        if constexpr (ALIGN_EPI) { if (wr == 1) PG8_BAR; }
    }
    PG8_WAIT_V(0);
    if constexpr (!ALIGN_EPI) { if (wr == 0) PG8_BAR; }
    PG8_BAR;
    if constexpr (Epi::AFTER_DRAIN) { E.fused(acc, cur, wr, wc, fr, fq, lds, wid, lane); S.done(cur); }
#undef PG8_SA
#undef PG8_SB
#undef PG8_STAGE
#undef PG8_LDA
#undef PG8_LDB
#undef PG8_MMA
#undef PG8_WAIT_V
#undef PG8_WAIT_L
#undef PG8_BAR
#undef PG8_SCHED
}
}


constexpr int NWAVES = 8, NTHR = NWAVES * 64;
#ifndef MK_N_LAUNCHES
#define MK_N_LAUNCHES 1
#endif
constexpr int N_PHASES = 10;
constexpr int N_LAUNCHES = MK_N_LAUNCHES;
constexpr int DM = 1024, M_CTX = pg8::M_CTX, L_CTX = 256, B_CTX = 16, M_LAT = 8192, L_LAT = 2048, B_LAT = 4, M = M_CTX + M_LAT;
constexpr int NHEAD = 8, NKV = 2, HD = 128, KVW = 256, HYW = 512, NIN = 3072 + 2048, KMIX = 1024 + 512, DFF = 2816, NUP = 2 * DFF;
constexpr int NMOD = 6 * DM, MOD_KS = 16;
constexpr float EPS = 1e-6f;
constexpr int OUT_Y = 0, OUT_NEWK = M * DM, OUT_NEWV = OUT_NEWK + M_CTX * KVW;

constexpr size_t MiB = 1u << 20;
constexpr size_t WS_CTL = 0, CTL_ZERO_BYTES = 1 * MiB;
constexpr size_t WS_W1 = 2 * MiB;
constexpr size_t WS_W2 = 12 * MiB;
constexpr size_t WS_W3 = 15 * MiB;
constexpr size_t WS_W4 = 17 * MiB;
constexpr size_t WS_W5 = 28 * MiB;
constexpr size_t WS_MODP = 34 * MiB;
constexpr size_t WS_MOD = 36 * MiB;
constexpr size_t WS_ROPE = 36 * MiB + 256 * 1024;
constexpr size_t WS_CK = 37 * MiB;
constexpr size_t WS_CV = 37 * MiB + 512 * 1024;
constexpr size_t WS_FCTX = 38 * MiB;
constexpr size_t WS_FLAT = 39 * MiB;
constexpr size_t WS_XN = 48 * MiB;
constexpr size_t WS_Q = 72 * MiB;
constexpr size_t WS_K = 96 * MiB;
constexpr size_t WS_V = 102 * MiB;
constexpr size_t WS_HY = 108 * MiB;
constexpr size_t WS_GT = 144 * MiB;
constexpr size_t WS_AH = 192 * MiB;
constexpr size_t WS_MG = 228 * MiB;
constexpr size_t WS_ACT = 72 * MiB;
constexpr size_t WS_F32 = 144 * MiB;
constexpr size_t WS_END = 252 * MiB;
static_assert(WS_ACT + (size_t)M * DFF * 2 <= WS_GT && WS_F32 + (size_t)M * DM * 4 <= WS_AH && WS_MG + (size_t)M * DM * 2 <= WS_END, "d_ws map");
constexpr int CW_TMO = 0, CW_CODE = 1, CW_BAR = 4096;

constexpr int RING_OFF = 0, RING_BYTES = 131072;
constexpr int LDSCTL_OFF = RING_BYTES, MISC_OFF = LDSCTL_OFF + 320;
constexpr int LDS_BYTES = 147456;
static_assert(MISC_OFF + 128 <= LDS_BYTES, "LDS map");

#define GAS __attribute__((address_space(1)))
#define LAS __attribute__((address_space(3)))
typedef unsigned short bf16;
typedef unsigned v4u __attribute__((ext_vector_type(4)));
typedef unsigned v2u __attribute__((ext_vector_type(2)));
typedef float f32x4 __attribute__((ext_vector_type(4)));
typedef GAS unsigned gu32;
#define RLX_AGENT __ATOMIC_RELAXED, __HIP_MEMORY_SCOPE_AGENT
#define LDS_WAIT() asm volatile("s_waitcnt lgkmcnt(0)" ::: "memory")
#define VM_WAIT() asm volatile("s_waitcnt vmcnt(0)" ::: "memory")
__device__ __forceinline__ unsigned f2bf(float f) { unsigned u = __builtin_bit_cast(unsigned, f); return (u + 0x7fffu + ((u >> 16) & 1u)) >> 16; }
__device__ __forceinline__ unsigned pk2(float lo, float hi) { return f2bf(lo) | (f2bf(hi) << 16); }
__device__ __forceinline__ float bf2f(bf16 v) { return __uint_as_float((unsigned)v << 16); }
__device__ __forceinline__ float wave_sum(float v) {
#pragma unroll
    for (int o = 1; o < 64; o <<= 1) v += __shfl_xor(v, o);
    return v;
}
__device__ __forceinline__ float wave_max(float v) {
#pragma unroll
    for (int o = 1; o < 64; o <<= 1) v = fmaxf(v, __shfl_xor(v, o));
    return v;
}

#define XB_TMO      128
#define XB_XCNT(j)  (256  + 64 * (j))
#define XB_XSUB(j)  (1280 + 64 * (j))
#define XB_XGEN(j)  (2304 + 64 * (j))
#define XB_TOP      3328
#define XB_TOPGEN   3392
#define XCD_BAR_WORDS 3456
#define XB_SPIN_CAP (1u << 18)

__device__ __forceinline__ unsigned xb_ld(unsigned* p)              { return __hip_atomic_load(p, __ATOMIC_RELAXED, __HIP_MEMORY_SCOPE_AGENT); }
__device__ __forceinline__ unsigned xb_add(unsigned* p, unsigned v) { return __hip_atomic_fetch_add(p, v, __ATOMIC_RELAXED, __HIP_MEMORY_SCOPE_AGENT); }
__device__ __forceinline__ unsigned xb_xcc_id() { return (unsigned)__builtin_amdgcn_s_getreg((3 << 11) | 20) & 0xFu; }
#define XB_SPIN(cond, bar) do { unsigned _sp = 0; while (cond) { __builtin_amdgcn_s_sleep(1); \
    if ((++_sp & 255u) == 0u) { if (xb_ld(&(bar)[XB_TMO])) break; if (_sp > XB_SPIN_CAP) { atomicAdd(&(bar)[XB_TMO], 1u); break; } } } } while (0)

struct XcdBarrier {
    unsigned* bar; unsigned x;
    volatile LAS unsigned* st;
};

__device__ __forceinline__ XcdBarrier xcd_barrier_post(unsigned* bar, volatile LAS unsigned* st, int wave) {
    XcdBarrier b; b.bar = bar; b.x = xb_xcc_id(); b.st = st;
    if (wave == 0 && lane_id() == 0) (void)xb_add(&bar[XB_XCNT(b.x)], 1u);
    return b;
}
__device__ __forceinline__ void xcd_barrier_complete(unsigned* bar, unsigned x, unsigned& nloc, unsigned& nx) {
    const unsigned G = gridDim.x * gridDim.y * gridDim.z;
    unsigned sum, cnt, mine, sp = 0u;
    for (;;) {
        sum = 0u; cnt = 0u; mine = 0u;
#pragma unroll
        for (unsigned j = 0; j < 16; ++j) { const unsigned c = xb_ld(&bar[XB_XCNT(j)]); sum += c; cnt += (c > 0u) ? 1u : 0u; mine = (j == x) ? c : mine; }
        if (sum == G) break;
        __builtin_amdgcn_s_sleep(1);
        if ((++sp & 255u) == 0u) { if (xb_ld(&bar[XB_TMO])) break; if (sp > XB_SPIN_CAP) { atomicAdd(&bar[XB_TMO], 1u); break; } }
    }
    nloc = mine > 0u ? mine : 1u; nx = cnt > 0u ? cnt : 1u;
}

__device__ __forceinline__ void xcd_barrier(const XcdBarrier& b, int wave) {
    asm volatile("s_waitcnt vmcnt(0)" ::: "memory");
    __syncthreads();
    if (wave == 0 && lane_id() == 0) {
        unsigned* bar = b.bar;
        __builtin_amdgcn_s_waitcnt(0);
        unsigned nloc = b.st[0], nx = b.st[1];
        if (nloc == 0u) { xcd_barrier_complete(bar, b.x, nloc, nx); b.st[0] = nloc; b.st[1] = nx; }
        const unsigned old = xb_add(&bar[XB_XSUB(b.x)], 1u);
        const unsigned gen = old / nloc;
        if (old + 1u == (gen + 1u) * nloc) {
            __builtin_amdgcn_fence(__ATOMIC_RELEASE, "agent");
            asm volatile("s_waitcnt vmcnt(0)" ::: "memory");
            const unsigned og = xb_add(&bar[XB_TOP], 1u);
            const unsigned tg = og / nx;
            if (og + 1u == (tg + 1u) * nx) xb_add(&bar[XB_TOPGEN], 1u);
            else XB_SPIN(xb_ld(&bar[XB_TOPGEN]) == tg, bar);
            __builtin_amdgcn_fence(__ATOMIC_ACQUIRE, "agent");
            xb_add(&bar[XB_XGEN(b.x)], 1u);
            asm volatile("s_waitcnt vmcnt(0)" ::: "memory");
        } else {
            XB_SPIN(xb_ld(&bar[XB_XGEN(b.x)]) == gen, bar);
            __builtin_amdgcn_fence(__ATOMIC_ACQUIRE, "agent");
            asm volatile("s_waitcnt vmcnt(0)" ::: "memory");
        }
    }
    __syncthreads();
}

struct Args { const float* in[33]; float* out; unsigned char* ws; int ph_lo, ph_hi, li, pad; };
struct Frame {
    LAS unsigned char* lds;
    volatile LAS unsigned* MISC;
    gu32* ctl;
    int wave;
    int vcu, G;
    float* out; unsigned char* ws;
};
typedef const float* const __attribute__((address_space(4))) * kargp_t;
__device__ __forceinline__ const float* inp(int i) { return ((kargp_t)__builtin_amdgcn_kernarg_segment_ptr())[i]; }
enum { I_XP = 0, I_XS, I_C, I_CK, I_CV, I_CCTX, I_NMPRE, I_NMPOST, I_NFPRE, I_NFPOST, I_WMOD, I_BMOD, I_WIN, I_SINK, I_CONVW, I_CONVB,
       I_FW1, I_FB1, I_FFR1, I_FW2, I_FB2, I_FFR2, I_FW3, I_FB3, I_FDEC, I_SKIP, I_WPA, I_WPH, I_WGATE, I_BGATE, I_WO, I_WUP, I_WDOWN };

__device__ __forceinline__ const float* xrow_ptr(const Args& A, int m) { return m < M_CTX ? inp(I_XP) + (size_t)m * DM : inp(I_XS) + (size_t)(m - M_CTX) * DM; }
__device__ __forceinline__ int mod_row(int m) { return m < M_CTX ? 0 : 1 + ((m - M_CTX) >> 11); }

template <class Map>
__device__ __forceinline__ void p0_transpose_item(const float* W, int K, int N, bf16* WT, int ldk, int koff, Map map, LAS float* scr, int item, int lane) {
    const int nblk = N / 32, kb = item / nblk, nb = item % nblk, k0 = 64 * kb, n0 = 32 * nb;
#pragma unroll 8
    for (int i = 0; i < 32; ++i) { const int kk = 2 * i + (lane >> 5); scr[kk * 33 + (lane & 31)] = W[(size_t)(k0 + kk) * N + n0 + (lane & 31)]; }
    LDS_WAIT(); asm volatile("" ::: "memory");
    const int c = lane & 7;
#pragma unroll
    for (int j = 0; j < 4; ++j) { const int n = (lane >> 3) + 8 * j; const LAS float* s = scr + (8 * c) * 33 + n;
        v4u o; o.x = pk2(s[0 * 33], s[1 * 33]); o.y = pk2(s[2 * 33], s[3 * 33]); o.z = pk2(s[4 * 33], s[5 * 33]); o.w = pk2(s[6 * 33], s[7 * 33]);
        *(GAS v4u*)(WT + (size_t)map(n0 + n) * ldk + koff + k0 + 8 * c) = o; }
    LDS_WAIT(); asm volatile("" ::: "memory");
}
struct MapIn {
    __device__ __forceinline__ int operator()(int n) const {
        if (n >= 1280) return n;
        const int d = n & 127, half = d >> 6, r = d & 63, nn = r >> 5, q = r & 31, idx8 = q >> 2, j = q & 3, wc = half * 2 + (idx8 >> 2), fq = idx8 & 3;
        return (n & ~127) + 32 * wc + 8 * fq + 4 * nn + j; }
};
struct MapOff { int off; __device__ __forceinline__ int operator()(int n) const { return n + off; } };
struct MapUp {
    __device__ __forceinline__ int operator()(int n) const { const int up = n >= DFF ? 1 : 0, i = n - up * DFF; return (i >> 7) * 256 + up * 128 + (i & 127); }
};

__device__ __forceinline__ float silu_f(float x) { return x / (1.0f + __expf(-x)); }

__device__ __forceinline__ void p0_filter_item(const Frame& F, const Args& A, int t, int L, float* FILT, int lane) {
    const float tn = (float)t / (float)L;
    const float base = (6.283185307179586f * (float)t) / (float)L;
    float s = inp(I_FB1)[lane] + tn * inp(I_FW1)[lane];
#pragma unroll
    for (int i = 0; i < 8; ++i) { const float band = 1e-4f + (float)i * ((7.0f - 1e-4f) / 7.0f); const float ang = base * band;
        s += cosf(ang) * inp(I_FW1)[(1 + i) * 64 + lane] + sinf(ang) * inp(I_FW1)[(9 + i) * 64 + lane]; }
    const float h1 = sinf(inp(I_FFR1)[lane] * s);
    float s2 = inp(I_FB2)[lane];
#pragma unroll 8
    for (int j = 0; j < 64; ++j) s2 += __shfl(h1, j) * inp(I_FW2)[j * 64 + lane];
    const float h2 = sinf(inp(I_FFR2)[lane] * s2);
    float acc[16];
#pragma unroll
    for (int cc = 0; cc < 16; ++cc) acc[cc] = inp(I_FB3)[cc * 64 + lane];
    for (int j = 0; j < 64; ++j) { const float hj = __shfl(h2, j); const float* w = inp(I_FW3) + (size_t)j * 1024 + lane;
#pragma unroll
        for (int cc = 0; cc < 16; ++cc) acc[cc] += hj * w[cc * 64]; }
#pragma unroll
    for (int cc = 0; cc < 16; ++cc) { const int col = cc * 64 + lane; FILT[(size_t)t * 1024 + col] = acc[cc] * __expf(-tn * fabsf(inp(I_FDEC)[col])); }
}

__device__ __forceinline__ void p0_prologue(Frame& F, const Args& A) {
    const int L_lane = lane_id();
    LAS float* scr = (LAS float*)(F.lds + RING_OFF + F.wave * 16384);
    const int gw = F.vcu * NWAVES + F.wave, NGW = F.G * NWAVES, lane = L_lane;
    bf16* W1 = (bf16*)(F.ws + WS_W1); bf16* W2 = (bf16*)(F.ws + WS_W2); bf16* W3 = (bf16*)(F.ws + WS_W3); bf16* W4 = (bf16*)(F.ws + WS_W4); bf16* W5 = (bf16*)(F.ws + WS_W5);
    constexpr int N_FILT = L_CTX + L_LAT;
    constexpr int T_IN = (DM / 64) * (3072 / 32), T_GATE = (DM / 64) * (2048 / 32), T_PA = (DM / 64) * (DM / 32), T_PH = (HYW / 64) * (DM / 32), T_O = T_PA,
                  T_UP = (DM / 64) * (NUP / 32), T_DOWN = (DFF / 64) * (DM / 32);
    constexpr int N_MODI = (NMOD / 256) * MOD_KS, N_ROPE = 32, N_CACHE = 2 * (B_LAT * 256 * KVW) / 512;
    constexpr int NITEMS = N_FILT + T_IN + T_GATE + T_PA + T_PH + T_O + T_UP + T_DOWN + N_MODI + N_ROPE + N_CACHE;
    for (int it = gw; it < NITEMS; it += NGW) {
        int r = it;
        if (r < N_FILT) { if (r < L_LAT) p0_filter_item(F, A, r, L_LAT, (float*)(F.ws + WS_FLAT), lane); else p0_filter_item(F, A, r - L_LAT, L_CTX, (float*)(F.ws + WS_FCTX), lane); continue; } r -= N_FILT;
        if (r < T_IN) { p0_transpose_item(inp(I_WIN), DM, 3072, W1, DM, 0, MapIn{}, scr, r, lane); continue; } r -= T_IN;
        if (r < T_GATE) { p0_transpose_item(inp(I_WGATE), DM, 2048, W1, DM, 0, MapOff{3072}, scr, r, lane); continue; } r -= T_GATE;
        if (r < T_PA) { p0_transpose_item(inp(I_WPA), DM, DM, W2, KMIX, 0, MapOff{0}, scr, r, lane); continue; } r -= T_PA;
        if (r < T_PH) { p0_transpose_item(inp(I_WPH), HYW, DM, W2, KMIX, DM, MapOff{0}, scr, r, lane); continue; } r -= T_PH;
        if (r < T_O) { p0_transpose_item(inp(I_WO), DM, DM, W3, DM, 0, MapOff{0}, scr, r, lane); continue; } r -= T_O;
        if (r < T_UP) { p0_transpose_item(inp(I_WUP), DM, NUP, W4, DM, 0, MapUp{}, scr, r, lane); continue; } r -= T_UP;
        if (r < T_DOWN) { p0_transpose_item(inp(I_WDOWN), DFF, DM, W5, DFF, 0, MapOff{0}, scr, r, lane); continue; } r -= T_DOWN;
        if (r < N_MODI) {
            const int cg = r / MOD_KS, ks = r % MOD_KS, col = cg * 256 + lane * 4;
            f32x4 acc[5];
#pragma unroll
            for (int q = 0; q < 5; ++q) acc[q] = (f32x4){0.f, 0.f, 0.f, 0.f};
            for (int k = ks * 64; k < ks * 64 + 64; ++k) {
                const f32x4 w = *(const f32x4*)(inp(I_WMOD) + (size_t)k * NMOD + col);
                acc[0] += silu_f(inp(I_CCTX)[k]) * w;
#pragma unroll
                for (int q = 1; q < 5; ++q) acc[q] += silu_f(inp(I_C)[(q - 1) * DM + k]) * w;
            }
            float* mp = (float*)(F.ws + WS_MODP) + (size_t)ks * 5 * NMOD + col;
#pragma unroll
            for (int q = 0; q < 5; ++q) *(f32x4*)(mp + q * NMOD) = acc[q];
            continue; } r -= N_MODI;
        if (r < N_ROPE) {
            const int pos = 2 * r + (lane >> 5), f = lane & 31;
            const float inv = expf(-(float)f * (9.210340371976184f / 32.0f));
            const float ang = (float)pos * inv;
            float* rp = (float*)(F.ws + WS_ROPE) + (size_t)(pos * 32 + f) * 2; rp[0] = cosf(ang); rp[1] = sinf(ang);
            continue; } r -= N_ROPE;
        {
            const int half = (B_LAT * 256 * KVW) / 512; const bool isv = r >= half; const int idx = (isv ? r - half : r) * 512 + lane * 8;
            const float* src = (isv ? inp(I_CV) : inp(I_CK)) + idx; bf16* dst = (bf16*)(F.ws + (isv ? WS_CV : WS_CK)) + idx;
            const f32x4 a = *(const f32x4*)src, b = *(const f32x4*)(src + 4);
            v4u o; o.x = pk2(a.x, a.y); o.y = pk2(a.z, a.w); o.z = pk2(b.x, b.y); o.w = pk2(b.z, b.w); *(v4u*)dst = o;
        }
    }
}

__device__ __forceinline__ float mod_total(const Frame& F, const Args& A, int r, int col) {
    const float* mp = (const float*)(F.ws + WS_MODP) + (size_t)r * NMOD + col; float s = inp(I_BMOD)[col];
#pragma unroll
    for (int ks = 0; ks < MOD_KS; ++ks) s += mp[(size_t)ks * 5 * NMOD];
    return s;
}
__device__ __forceinline__ void p1_rows(Frame& F, const Args& A) {
    const int L_lane = lane_id(), L_tid = F.wave * 64 + L_lane;
    if (F.vcu < 30) {
        const int r = F.vcu / 6, c0 = (F.vcu % 6) * 1024;
        for (int i = L_tid; i < 1024; i += NTHR) ((float*)(F.ws + WS_MOD))[r * NMOD + c0 + i] = mod_total(F, A, r, c0 + i);
    }
    LAS float* vA = (LAS float*)(F.lds + RING_OFF); LAS float* vB = vA + DM;
    int cur = -1;
    bf16* XN = (bf16*)(F.ws + WS_XN);
    for (int ch = 0; ch < 3; ++ch) {
        const int row0 = F.vcu * 48 + ch * 16;
        if (row0 >= M) break;
        const int r = mod_row(row0);
        if (r != cur) {
            __syncthreads();
            for (int i = L_tid; i < DM; i += NTHR) { vA[i] = inp(I_NMPRE)[i] * (1.0f + mod_total(F, A, r, DM + i)); vB[i] = mod_total(F, A, r, i); }
            __syncthreads(); cur = r;
        }
#pragma unroll 1
        for (int q = 0; q < 2; ++q) {
            const int m = row0 + F.wave * 2 + q;
            const f32x4* xr = (const f32x4*)xrow_ptr(A, m) + L_lane;
            f32x4 v[4]; float s = 0.f;
#pragma unroll
            for (int j = 0; j < 4; ++j) { v[j] = xr[64 * j]; s += (v[j].x * v[j].x + v[j].y * v[j].y) + (v[j].z * v[j].z + v[j].w * v[j].w); }
            const float rstd = 1.0f / sqrtf(wave_sum(s) * (1.0f / DM) + EPS);
            unsigned long long* o8 = (unsigned long long*)(XN + (size_t)m * DM) + L_lane;
#pragma unroll
            for (int j = 0; j < 4; ++j) { const int c = 4 * L_lane + 256 * j;
                const float a = v[j].x * rstd * vA[c] + vB[c], b = v[j].y * rstd * vA[c + 1] + vB[c + 1], cc = v[j].z * rstd * vA[c + 2] + vB[c + 2], d = v[j].w * rstd * vA[c + 3] + vB[c + 3];
                o8[64 * j] = (unsigned long long)pk2(a, b) | ((unsigned long long)pk2(cc, d) << 32); }
        }
    }
}

__device__ __forceinline__ void attn_item_naive(const Frame& F, const Args& A, int m, int h, LAS float* sq, LAS float* sp) {
    const int lane = lane_id(), kv = h >> 2;
    const bf16* Qb = (const bf16*)(F.ws + WS_Q); const bf16* Kb = (const bf16*)(F.ws + WS_K); const bf16* Vb = (const bf16*)(F.ws + WS_V);
    const bf16* CK = (const bf16*)(F.ws + WS_CK); const bf16* CV = (const bf16*)(F.ws + WS_CV);
    const bf16* qrow = Qb + (size_t)m * DM + h * HD;
    sq[lane] = bf2f(qrow[lane]); sq[lane + 64] = bf2f(qrow[lane + 64]);
    int nwin, nk; size_t wrow0, crow0;
    if (m < M_CTX) { const int b = m >> 8; nwin = 256; nk = 256; wrow0 = (size_t)b * 256; crow0 = 0; }
    else { const int mm = m - M_CTX, b = mm >> 11, t = mm & 2047; const int lo = t - 128 < 0 ? 0 : t - 128, hi = t + 128 > 2047 ? 2047 : t + 128;
        nwin = hi - lo + 1; nk = nwin + 256; wrow0 = (size_t)M_CTX + (size_t)b * 2048 + lo; crow0 = (size_t)b * 256; }
    float s[9];
#pragma unroll
    for (int it = 0; it < 9; ++it) {
        const int kk = it * 64 + lane; s[it] = -3.0e38f;
        if (kk < nk) {
            const bf16* kr = (kk < nwin) ? Kb + (wrow0 + kk) * KVW + kv * HD : CK + (crow0 + (kk - nwin)) * KVW + kv * HD;
            float d = 0.f;
#pragma unroll
            for (int c = 0; c < 16; ++c) { const v4u w = *(const v4u*)(kr + c * 8); const LAS float* q8 = sq + c * 8;
                d += q8[0] * __uint_as_float(w.x << 16) + q8[1] * __uint_as_float(w.x & 0xffff0000u) + q8[2] * __uint_as_float(w.y << 16) + q8[3] * __uint_as_float(w.y & 0xffff0000u)
                   + q8[4] * __uint_as_float(w.z << 16) + q8[5] * __uint_as_float(w.z & 0xffff0000u) + q8[6] * __uint_as_float(w.w << 16) + q8[7] * __uint_as_float(w.w & 0xffff0000u); }
            s[it] = d;
        }
    }
    const float sinkl = inp(I_SINK)[h] * 1.4426950408889634f;
    float mx = s[0];
#pragma unroll
    for (int it = 1; it < 9; ++it) mx = fmaxf(mx, s[it]);
    mx = fmaxf(wave_max(mx), sinkl);
    float sum = 0.f;
#pragma unroll
    for (int it = 0; it < 9; ++it) { const int kk = it * 64 + lane; const float p = (kk < nk) ? exp2f(s[it] - mx) : 0.f; sum += p; if (kk < nk) sp[kk] = p; }
    sum = wave_sum(sum) + exp2f(sinkl - mx);
    float o0 = 0.f, o1 = 0.f;
    for (int kk = 0; kk < nk; ++kk) {
        const bf16* vr = (kk < nwin) ? Vb + (wrow0 + kk) * KVW + kv * HD : CV + (crow0 + (kk - nwin)) * KVW + kv * HD;
        const float p = sp[kk]; o0 += p * bf2f(vr[lane]); o1 += p * bf2f(vr[lane + 64]);
    }
    const float inv = 1.0f / sum;
    bf16* orow = (bf16*)(F.ws + WS_AH) + (size_t)m * KMIX + h * HD;
    orow[lane] = (bf16)f2bf(o0 * inv); orow[lane + 64] = (bf16)f2bf(o1 * inv);
}
__device__ __forceinline__ void hyena_row_naive(const Frame& F, const Args& A, int m) {
    const int L_tid = F.wave * 64 + lane_id();
    const int c = L_tid;
    const bool ctx = m < M_CTX; const int L = ctx ? L_CTX : L_LAT; const int t = ctx ? (m & 255) : ((m - M_CTX) & 2047); const size_t base = (size_t)(m - t);
    const float* FILT = (const float*)(F.ws + (ctx ? WS_FCTX : WS_FLAT));
    const bf16* HY = (const bf16*)(F.ws + WS_HY);
    const float* cw = inp(I_CONVW); const float* cb = inp(I_CONVB);
    const float a0 = cw[c], a1 = cw[1536 + c], a2 = cw[3072 + c], ab = cb[c];
    const float b0 = cw[512 + c], b1 = cw[1536 + 512 + c], b2 = cw[3072 + 512 + c], bb = cb[512 + c];
    const float v0 = cw[1024 + c], v1 = cw[1536 + 1024 + c], v2 = cw[3072 + 1024 + c], vb = cb[1024 + c];
    const float xm = t > 0 ? bf2f(HY[(base + t - 1) * 1536 + c]) : 0.f, xc = bf2f(HY[(base + t) * 1536 + c]), xp = t + 1 < L ? bf2f(HY[(base + t + 1) * 1536 + c]) : 0.f;
    const float x0 = a0 * xm + a1 * xc + a2 * xp + ab;
    float p1 = 0.f, c1 = bf2f(HY[base * 1536 + 512 + c]), pv = 0.f, cv = bf2f(HY[base * 1536 + 1024 + c]);
    float acc = 0.f, zt = 0.f;
    for (int s = 0; s < L; ++s) {
        const float n1 = s + 1 < L ? bf2f(HY[(base + s + 1) * 1536 + 512 + c]) : 0.f, nv = s + 1 < L ? bf2f(HY[(base + s + 1) * 1536 + 1024 + c]) : 0.f;
        const float u1 = b0 * p1 + b1 * c1 + b2 * n1 + bb, uv = v0 * pv + v1 * cv + v2 * nv + vb;
        const float z = u1 * uv;
        const float tap = (s <= t) ? FILT[(size_t)(t - s) * 1024 + c] : FILT[(size_t)(s - t) * 1024 + 512 + c];
        acc += tap * z; if (s == t) zt = z;
        p1 = c1; c1 = n1; pv = cv; cv = nv;
    }
    const float y = acc + zt * inp(I_SKIP)[c];
    ((bf16*)(F.ws + WS_AH))[(size_t)m * KMIX + 1024 + c] = (bf16)f2bf(x0 * y);
}
__device__ __forceinline__ void p3_mixer_naive(Frame& F, const Args& A) {
    LAS float* sq = (LAS float*)(F.lds + RING_OFF + F.wave * 4096); LAS float* sp = sq + 128;
    const int gw = F.vcu * NWAVES + F.wave, NGW = F.G * NWAVES;
    for (int it = gw; it < M * NHEAD; it += NGW) attn_item_naive(F, A, it >> 3, it & 7, sq, sp);
    for (int m = F.vcu; m < M; m += F.G) hyena_row_naive(F, A, m);
}

__device__ __forceinline__ void p6_rows(Frame& F, const Args& A) {
    const int L_lane = lane_id();
    const int gw = F.vcu * NWAVES + F.wave, NGW = F.G * NWAVES;
    const float* MIX = (const float*)(F.ws + WS_F32); const float* MOD = (const float*)(F.ws + WS_MOD); bf16* XN = (bf16*)(F.ws + WS_XN);
    for (int m = gw; m < M; m += NGW) {
        const float* mod = MOD + (size_t)mod_row(m) * NMOD;
        const f32x4* xr = (const f32x4*)xrow_ptr(A, m) + L_lane; const f32x4* mr = (const f32x4*)(MIX + (size_t)m * DM) + L_lane;
        f32x4 v[4]; float s = 0.f;
#pragma unroll
        for (int j = 0; j < 4; ++j) { v[j] = mr[64 * j]; s += (v[j].x * v[j].x + v[j].y * v[j].y) + (v[j].z * v[j].z + v[j].w * v[j].w); }
        const float rstd = 1.0f / sqrtf(wave_sum(s) * (1.0f / DM) + EPS);
        float s2 = 0.f;
#pragma unroll
        for (int j = 0; j < 4; ++j) { const int c = 4 * L_lane + 256 * j;
            const f32x4 g1 = *(const f32x4*)(mod + 2 * DM + c), wp = *(const f32x4*)(inp(I_NMPOST) + c);
            v[j] = xr[64 * j] + g1 * (v[j] * rstd * wp);
            s2 += (v[j].x * v[j].x + v[j].y * v[j].y) + (v[j].z * v[j].z + v[j].w * v[j].w);
            *(f32x4*)(F.out + (size_t)m * DM + c) = v[j]; }
        const float rstd2 = 1.0f / sqrtf(wave_sum(s2) * (1.0f / DM) + EPS);
        unsigned long long* o8 = (unsigned long long*)(XN + (size_t)m * DM) + L_lane;
#pragma unroll
        for (int j = 0; j < 4; ++j) { const int c = 4 * L_lane + 256 * j;
            const f32x4 sh2 = *(const f32x4*)(mod + 3 * DM + c), sc2 = *(const f32x4*)(mod + 4 * DM + c), wp = *(const f32x4*)(inp(I_NFPRE) + c);
            const f32x4 hh = v[j] * rstd2 * wp * (1.0f + sc2) + sh2;
            o8[64 * j] = (unsigned long long)pk2(hh.x, hh.y) | ((unsigned long long)pk2(hh.z, hh.w) << 32); }
    }
}
__device__ __forceinline__ void p9_rows(Frame& F, const Args& A) {
    const int L_lane = lane_id();
    const int gw = F.vcu * NWAVES + F.wave, NGW = F.G * NWAVES;
    const float* FF = (const float*)(F.ws + WS_F32); const float* MOD = (const float*)(F.ws + WS_MOD);
    for (int m = gw; m < M; m += NGW) {
        const float* mod = MOD + (size_t)mod_row(m) * NMOD;
        const f32x4* fr = (const f32x4*)(FF + (size_t)m * DM) + L_lane;
        f32x4 v[4]; float s = 0.f;
#pragma unroll
        for (int j = 0; j < 4; ++j) { v[j] = fr[64 * j]; s += (v[j].x * v[j].x + v[j].y * v[j].y) + (v[j].z * v[j].z + v[j].w * v[j].w); }
        const float rstd = 1.0f / sqrtf(wave_sum(s) * (1.0f / DM) + EPS);
#pragma unroll
        for (int j = 0; j < 4; ++j) { const int c = 4 * L_lane + 256 * j;
            const f32x4 g2 = *(const f32x4*)(mod + 5 * DM + c), wp = *(const f32x4*)(inp(I_NFPOST) + c);
            float* o = F.out + (size_t)m * DM + c; *(f32x4*)o = *(const f32x4*)o + g2 * (v[j] * rstd * wp); }
    }
}

__global__ void __launch_bounds__(NTHR, 2) fwd_kernel(const Args args) {
    extern __shared__ __attribute__((aligned(16))) unsigned char lds[];
    Frame F;
    F.lds = (LAS unsigned char*)lds;
    F.MISC = (volatile LAS unsigned*)(F.lds + MISC_OFF);
    F.wave = __builtin_amdgcn_readfirstlane(threadIdx.x >> 6);
    F.G = gridDim.x; { const int bx = blockIdx.x; F.vcu = (F.G % 8 == 0) ? (bx % 8) * (F.G / 8) + bx / 8 : bx; }
    F.out = args.out; F.ws = args.ws;
    F.ctl = (gu32*)(F.ws + WS_CTL);
    for (int u = F.wave * 64 + lane_id(); u < (LDS_BYTES - LDSCTL_OFF) / 4; u += NTHR) ((LAS unsigned*)(F.lds + LDSCTL_OFF))[u] = 0u;
    __syncthreads();
    XcdBarrier bar; bar.bar = (unsigned*)(F.ctl + CW_BAR); bar.x = 0; bar.st = nullptr;
    if (N_LAUNCHES == 1) bar = xcd_barrier_post((unsigned*)(F.ctl + CW_BAR), F.MISC + 8, F.wave);
#define GRID_BAR() do { if (N_LAUNCHES == 1) xcd_barrier(bar, F.wave); } while (0)
    const int lo = args.ph_lo, hi = args.ph_hi;
#define IN(k) (lo <= (k) && (k) < hi)
#define BOTH(k) (IN(k) && IN((k) + 1))
    bf16* const XN = (bf16*)(F.ws + WS_XN);
    if (IN(0)) { p0_prologue(F, args); if (BOTH(0)) GRID_BAR(); }
    if (IN(1)) { p1_rows(F, args); if (BOTH(1)) GRID_BAR(); }
    if (IN(2)) {
        pg8::Gemm g{XN, (const bf16*)(F.ws + WS_W1), M, NIN, DM}; pg8::StaticOrder S; S.init(M, NIN, F.G, (int)blockIdx.x);
        pg8::EpiIn E{(bf16*)(F.ws + WS_Q), (bf16*)(F.ws + WS_K), (bf16*)(F.ws + WS_V), (bf16*)(F.ws + WS_HY), (bf16*)(F.ws + WS_GT),
                     F.out + OUT_NEWK, F.out + OUT_NEWV, inp(I_BGATE), (const float*)(F.ws + WS_ROPE)};
        pg8::gemm_phase<pg8::EpiIn, pg8::StaticOrder, true, true>(F.lds + RING_OFF, g, S, E, F.wave);
        if (BOTH(2)) GRID_BAR();
    }
    if (IN(3)) { p3_mixer_naive(F, args); if (BOTH(3)) GRID_BAR(); }
    if (IN(4)) {
        pg8::Gemm g{(const bf16*)(F.ws + WS_AH), (const bf16*)(F.ws + WS_W2), M, DM, KMIX}; pg8::StaticOrder S; S.init(M, DM, F.G, (int)blockIdx.x);
        pg8::EpiMerge E{(const bf16*)(F.ws + WS_GT), (bf16*)(F.ws + WS_MG)};
        pg8::gemm_phase<pg8::EpiMerge, pg8::StaticOrder, false, true>(F.lds + RING_OFF, g, S, E, F.wave);
        if (BOTH(4)) GRID_BAR();
    }
    if (IN(5)) {
        pg8::Gemm g{(const bf16*)(F.ws + WS_MG), (const bf16*)(F.ws + WS_W3), M, DM, DM}; pg8::StaticOrder S; S.init(M, DM, F.G, (int)blockIdx.x);
        pg8::EpiF32 E{(float*)(F.ws + WS_F32), DM};
        pg8::gemm_phase<pg8::EpiF32, pg8::StaticOrder, false, true>(F.lds + RING_OFF, g, S, E, F.wave);
        if (BOTH(5)) GRID_BAR();
    }
    if (IN(6)) { p6_rows(F, args); if (BOTH(6)) GRID_BAR(); }
    if (IN(7)) {
        pg8::Gemm g{XN, (const bf16*)(F.ws + WS_W4), M, NUP, DM}; pg8::StaticOrder S; S.init(M, NUP, F.G, (int)blockIdx.x);
        pg8::EpiSwiGLU E{(bf16*)(F.ws + WS_ACT), DFF};
        pg8::gemm_phase<pg8::EpiSwiGLU, pg8::StaticOrder, true, true>(F.lds + RING_OFF, g, S, E, F.wave);
        if (BOTH(7)) GRID_BAR();
    }
    if (IN(8)) {
        pg8::Gemm g{(const bf16*)(F.ws + WS_ACT), (const bf16*)(F.ws + WS_W5), M, DM, DFF}; pg8::StaticOrder S; S.init(M, DM, F.G, (int)blockIdx.x);
        pg8::EpiF32 E{(float*)(F.ws + WS_F32), DM};
        pg8::gemm_phase<pg8::EpiF32, pg8::StaticOrder, false, true>(F.lds + RING_OFF, g, S, E, F.wave);
        if (BOTH(8)) GRID_BAR();
    }
    if (IN(9)) { p9_rows(F, args); }
#undef IN
#undef BOTH
}

extern "C" void kernel_launch(void* const* d_in, const int* in_sizes, int n_in, void* d_out, int out_size, void* d_ws, size_t ws_size, hipStream_t stream) {
    static int grid = 0;
    if (grid == 0) {
        if (n_in != 33 || out_size != M * DM + 2 * M_CTX * KVW || ws_size < WS_END) { fprintf(stderr, "kernel_launch: unexpected sizes n_in %d out %d ws %zu\n", n_in, out_size, ws_size); grid = -1; return; }
        int dev = 0, cus = 0, per_cu = 0;
        if (hipGetDevice(&dev) != hipSuccess || hipDeviceGetAttribute(&cus, hipDeviceAttributeMultiprocessorCount, dev) != hipSuccess) { grid = -1; return; }
        if (hipFuncSetAttribute((const void*)fwd_kernel, hipFuncAttributeMaxDynamicSharedMemorySize, LDS_BYTES) != hipSuccess) { fprintf(stderr, "kernel_launch: hipFuncSetAttribute failed\n"); grid = -1; return; }
        if (hipOccupancyMaxActiveBlocksPerMultiprocessor(&per_cu, (const void*)fwd_kernel, NTHR, LDS_BYTES) != hipSuccess || per_cu < 1) { fprintf(stderr, "kernel_launch: occupancy query says %d\n", per_cu); }
        (void)hipGetLastError();
        grid = cus;
        if (grid != 256) fprintf(stderr, "kernel_launch: %d CUs (expected 256)\n", grid);
    }
    if (grid < 0) return;
    (void)hipMemsetAsync((char*)d_ws + WS_CTL, 0, CTL_ZERO_BYTES, stream);
    Args a{};
    for (int i = 0; i < 33; ++i) a.in[i] = (const float*)d_in[i];
    a.out = (float*)d_out; a.ws = (unsigned char*)d_ws;
    for (int li = 0; li < N_LAUNCHES; ++li) {
        a.ph_lo = (N_LAUNCHES == 1) ? 0 : li; a.ph_hi = (N_LAUNCHES == 1) ? N_PHASES : li + 1; a.li = li;
        hipLaunchKernelGGL(fwd_kernel, dim3(grid), dim3(NTHR), LDS_BYTES, stream, a);
    }
}
```

```cpp
#include <hip/hip_runtime.h>
#include <cstdio>
#include <cstdint>
__device__ __forceinline__ int lane_id() { int l; asm volatile("v_mbcnt_lo_u32_b32 %0, -1, 0\n\tv_mbcnt_hi_u32_b32 %0, -1, %0" : "=v"(l)); return l; }
namespace pg8 {
#define PG8_LAS __attribute__((address_space(3)))
typedef unsigned short bf16_t;
typedef short bf16x8 __attribute__((ext_vector_type(8)));
typedef float f32x4 __attribute__((ext_vector_type(4)));
typedef unsigned u32x4 __attribute__((ext_vector_type(4)));
constexpr int BM = 256, BK = 64, HALF = 128, HTB = HALF * BK * 2  , STAGE_BYTES = 8 * HTB, NXCD = 8, WGM = 8;

__host__ __device__ __forceinline__ int lds_byte(int r, int c) { const int st = (r >> 4) * 2 + (c >> 5), rr = r & 15, cc = c & 31, ob = rr * 64 + cc * 2; return st * 1024 + (ob ^ (((ob >> 9) & 1) << 5)); }
__host__ __device__ __forceinline__ void stage_rc(int b, int& R, int& C) { const int st = b / 1024, sb = b % 1024, swz = sb ^ (((sb >> 9) & 1) << 5); R = (st >> 1) * 16 + swz / 64; C = (st & 1) * 32 + (swz % 64) / 2; }
__host__ __device__ __forceinline__ int perm32(int rho) { const int n = rho >> 4, i = rho & 15; return 8 * (i >> 2) + 4 * n + (i & 3); }

struct Unit { int pm, pn; };
struct Gemm { const bf16_t* A; const bf16_t* Bt; int M, N, K; };

struct StaticOrder {
    int nM, nN, nwg, G, c;
    __host__ __device__ void init(int M, int N, int G_, int c_) { nM = M / BM; nN = N / BM; nwg = nM * nN; G = G_; c = c_; }
    __host__ __device__ bool next(int i, Unit& u) const {
        const long L = (long)i * G + c; if (L >= nwg) return false;
        int wgid = (int)L; { const int q = nwg / NXCD, r = nwg % NXCD, xcd = wgid % NXCD, off = wgid / NXCD; wgid = (xcd < r ? xcd * (q + 1) : r * (q + 1) + (xcd - r) * q) + off; }
        const int nig = WGM * nN, gid = wgid / nig, fm = gid * WGM, gsz = (nM - fm) < WGM ? (nM - fm) : WGM;
        u.pm = fm + ((wgid % nig) % gsz); u.pn = (wgid % nig) / gsz; return true;
    }
    __device__ __forceinline__ void a_ready(const Unit&) const {}
    __device__ __forceinline__ void done(const Unit&) const {}
};


__device__ __forceinline__ unsigned cvt_pk_bf16(float lo, float hi) { unsigned r; asm volatile("v_cvt_pk_bf16_f32 %0, %1, %2" : "=v"(r) : "v"(lo), "v"(hi)); return r; }
typedef float f32x2 __attribute__((ext_vector_type(2)));
typedef unsigned u32x2 __attribute__((ext_vector_type(2)));
__device__ __forceinline__ float bf_lo(unsigned w) { return __uint_as_float(w << 16); }
__device__ __forceinline__ float bf_hi(unsigned w) { return __uint_as_float(w & 0xffff0000u); }
__device__ __forceinline__ float sigmoid_f(float x) { return __builtin_amdgcn_rcpf(1.0f + __builtin_amdgcn_exp2f(-1.4426950408889634f * x)); }

constexpr int M_CTX = 4096;
constexpr float QSCALE = 0.088388347648318440f * 1.4426950408889634f;

struct EpiF32 {
    static constexpr bool PERM = false, AFTER_DRAIN = false; static constexpr int MID_T = -1;
    float* C; int ldc;
    __device__ __forceinline__ void mid(f32x4 (&acc)[2][2][4][2], const Unit& u, int wr, int wc, int fr, int fq) const {}
    __device__ __forceinline__ void operator()(const f32x4 (&acc)[2][2][4][2], const Unit& u, int wr, int wc, int fr, int fq) const {
        const int row0 = u.pm * BM + wr * 64 + fr, col0 = u.pn * BM + wc * 32 + 4 * fq;
#pragma unroll
        for (int ai = 0; ai < 2; ++ai)
#pragma unroll
            for (int m = 0; m < 4; ++m) { float* rowp = C + (size_t)(row0 + ai * HALF + m * 16) * ldc + col0;
#pragma unroll
                for (int bj = 0; bj < 2; ++bj)
#pragma unroll
                    for (int n = 0; n < 2; ++n) *(f32x4*)(rowp + bj * HALF + n * 16) = acc[ai][bj][m][n]; }
    }
};

struct EpiIn {
    static constexpr bool PERM = true, AFTER_DRAIN = false; static constexpr int MID_T = -1;
    bf16_t *Q, *Kb, *Vb, *HY, *GT; float *newk, *newv; const float* bgate; const float* rope;
    __device__ __forceinline__ void mid(f32x4 (&acc)[2][2][4][2], const Unit& u, int wr, int wc, int fr, int fq) const {}
    __device__ __forceinline__ void operator()(const f32x4 (&acc)[2][2][4][2], const Unit& u, int wr, int wc, int fr, int fq) const {
        const int pn = u.pn, rowb = u.pm * BM + wr * 64 + fr;
        const bool latent = u.pm >= (M_CTX / BM);
        if (pn < 5) {
            const int fidx = ((wc & 1) * 4 + fq) * 4, d0 = (wc >> 1) * 64 + fidx;
            const bool isq = pn < 4; const float sc = isq ? QSCALE : 1.0f;
#pragma unroll
            for (int ai = 0; ai < 2; ++ai)
#pragma unroll
                for (int m = 0; m < 4; ++m) {
                    const int row = rowb + ai * HALF + m * 16;
                    f32x4 cs0 = (f32x4){1.f, 0.f, 1.f, 0.f}, cs1 = cs0;
                    if (latent) { const int t = (row - M_CTX) & 2047, pos = (wc >> 1) ? (t & 63) : (t >> 6);
                        const f32x4* rp = (const f32x4*)(rope + (size_t)(pos * 32 + fidx) * 2); cs0 = rp[0]; cs1 = rp[1]; }
#pragma unroll
                    for (int bj = 0; bj < 2; ++bj) {
                        const f32x4 x1 = acc[ai][bj][m][0], x2 = acc[ai][bj][m][1];
                        f32x4 o1, o2;
                        o1[0] = (x1[0] * cs0[0] - x2[0] * cs0[1]) * sc; o2[0] = (x1[0] * cs0[1] + x2[0] * cs0[0]) * sc;
                        o1[1] = (x1[1] * cs0[2] - x2[1] * cs0[3]) * sc; o2[1] = (x1[1] * cs0[3] + x2[1] * cs0[2]) * sc;
                        o1[2] = (x1[2] * cs1[0] - x2[2] * cs1[1]) * sc; o2[2] = (x1[2] * cs1[1] + x2[2] * cs1[0]) * sc;
                        o1[3] = (x1[3] * cs1[2] - x2[3] * cs1[3]) * sc; o2[3] = (x1[3] * cs1[3] + x2[3] * cs1[2]) * sc;
                        u32x2 w1, w2; w1.x = cvt_pk_bf16(o1[0], o1[1]); w1.y = cvt_pk_bf16(o1[2], o1[3]); w2.x = cvt_pk_bf16(o2[0], o2[1]); w2.y = cvt_pk_bf16(o2[2], o2[3]);
                        if (isq) { bf16_t* p = Q + (size_t)row * 1024 + (pn * 2 + bj) * 128 + d0; *(u32x2*)p = w1; *(u32x2*)(p + 32) = w2; }
                        else { bf16_t* p = Kb + (size_t)row * 256 + bj * 128 + d0; *(u32x2*)p = w1; *(u32x2*)(p + 32) = w2;
                            if (!latent) { float* q = newk + (size_t)row * 256 + bj * 128 + d0; *(f32x4*)q = o1; *(f32x4*)(q + 32) = o2; } }
                    }
                }
        } else {
            const int cin = wc * 32 + 8 * fq;
            bf16_t* base; int ld, col0;
            if (pn == 5) { base = Vb; ld = 256; col0 = 0; } else if (pn < 12) { base = HY; ld = 1536; col0 = (pn - 6) * BM; } else { base = GT; ld = 2048; col0 = (pn - 12) * BM; }
            f32x4 bv[2][2];
#pragma unroll
            for (int bj = 0; bj < 2; ++bj)
#pragma unroll
                for (int n = 0; n < 2; ++n) bv[bj][n] = (pn >= 12) ? *(const f32x4*)(bgate + col0 + bj * HALF + cin + 4 * n) : (f32x4){0.f, 0.f, 0.f, 0.f};
#pragma unroll
            for (int ai = 0; ai < 2; ++ai)
#pragma unroll
                for (int m = 0; m < 4; ++m) {
                    const int row = rowb + ai * HALF + m * 16;
#pragma unroll
                    for (int bj = 0; bj < 2; ++bj) {
                        f32x4 v0 = acc[ai][bj][m][0] + bv[bj][0], v1 = acc[ai][bj][m][1] + bv[bj][1];
                        if (pn >= 12) {
#pragma unroll
                            for (int j = 0; j < 4; ++j) { v0[j] = sigmoid_f(v0[j]); v1[j] = sigmoid_f(v1[j]); } }
                        u32x4 w; w.x = cvt_pk_bf16(v0[0], v0[1]); w.y = cvt_pk_bf16(v0[2], v0[3]); w.z = cvt_pk_bf16(v1[0], v1[1]); w.w = cvt_pk_bf16(v1[2], v1[3]);
                        *(u32x4*)(base + (size_t)row * ld + col0 + bj * HALF + cin) = w;
                        if (pn == 5 && !latent) { float* q = newv + (size_t)row * 256 + bj * HALF + cin; *(f32x4*)q = v0; *(f32x4*)(q + 4) = v1; }
                    }
                }
        }
    }
};

struct EpiMerge {
    static constexpr bool PERM = true, AFTER_DRAIN = false; static constexpr int MID_T = 16;
    const bf16_t* GT; bf16_t* MG;
    __device__ __forceinline__ void mid(f32x4 (&acc)[2][2][4][2], const Unit& u, int wr, int wc, int fr, int fq) const {
        const int rowb = u.pm * BM + wr * 64 + fr, colb = u.pn * BM + wc * 32 + 8 * fq;
#pragma unroll
        for (int ai = 0; ai < 2; ++ai)
#pragma unroll
            for (int m = 0; m < 4; ++m) {
                const bf16_t* g = GT + (size_t)(rowb + ai * HALF + m * 16) * 2048 + colb;
#pragma unroll
                for (int bj = 0; bj < 2; ++bj) {
                    const u32x4 ga = *(const u32x4*)(g + bj * HALF), gh = *(const u32x4*)(g + 1024 + bj * HALF);
                    f32x4& a0 = acc[ai][bj][m][0]; f32x4& a1 = acc[ai][bj][m][1];
                    a0[0] *= bf_lo(ga.x) * __builtin_amdgcn_rcpf(bf_lo(gh.x)); a0[1] *= bf_hi(ga.x) * __builtin_amdgcn_rcpf(bf_hi(gh.x));
                    a0[2] *= bf_lo(ga.y) * __builtin_amdgcn_rcpf(bf_lo(gh.y)); a0[3] *= bf_hi(ga.y) * __builtin_amdgcn_rcpf(bf_hi(gh.y));
                    a1[0] *= bf_lo(ga.z) * __builtin_amdgcn_rcpf(bf_lo(gh.z)); a1[1] *= bf_hi(ga.z) * __builtin_amdgcn_rcpf(bf_hi(gh.z));
                    a1[2] *= bf_lo(ga.w) * __builtin_amdgcn_rcpf(bf_lo(gh.w)); a1[3] *= bf_hi(ga.w) * __builtin_amdgcn_rcpf(bf_hi(gh.w));
                }
            }
    }
    __device__ __forceinline__ void operator()(const f32x4 (&acc)[2][2][4][2], const Unit& u, int wr, int wc, int fr, int fq) const {
        const int rowb = u.pm * BM + wr * 64 + fr, colb = u.pn * BM + wc * 32 + 8 * fq;
#pragma unroll
        for (int ai = 0; ai < 2; ++ai)
#pragma unroll
            for (int m = 0; m < 4; ++m) {
                const size_t ro = (size_t)(rowb + ai * HALF + m * 16);
#pragma unroll
                for (int bj = 0; bj < 2; ++bj) {
                    const u32x4 gh = *(const u32x4*)(GT + ro * 2048 + 1024 + colb + bj * HALF);
                    const f32x4 a0 = acc[ai][bj][m][0], a1 = acc[ai][bj][m][1];
                    u32x4 w; w.x = cvt_pk_bf16(a0[0] * bf_lo(gh.x), a0[1] * bf_hi(gh.x)); w.y = cvt_pk_bf16(a0[2] * bf_lo(gh.y), a0[3] * bf_hi(gh.y));
                    w.z = cvt_pk_bf16(a1[0] * bf_lo(gh.z), a1[1] * bf_hi(gh.z)); w.w = cvt_pk_bf16(a1[2] * bf_lo(gh.w), a1[3] * bf_hi(gh.w));
                    *(u32x4*)(MG + ro * 1024 + colb + bj * HALF) = w;
                }
            }
    }
};

struct EpiSwiGLU {
    static constexpr bool PERM = true, AFTER_DRAIN = false; static constexpr int MID_T = -1;
    bf16_t* ACT; int ld;
    __device__ __forceinline__ void mid(f32x4 (&acc)[2][2][4][2], const Unit& u, int wr, int wc, int fr, int fq) const {}
    __device__ __forceinline__ void operator()(const f32x4 (&acc)[2][2][4][2], const Unit& u, int wr, int wc, int fr, int fq) const {
        const int rowb = u.pm * BM + wr * 64 + fr, colb = u.pn * HALF + wc * 32 + 8 * fq;
#pragma unroll
        for (int ai = 0; ai < 2; ++ai)
#pragma unroll
            for (int m = 0; m < 4; ++m) {
                float o[8];
#pragma unroll
                for (int n = 0; n < 2; ++n)
#pragma unroll
                    for (int j = 0; j < 4; ++j) { const float g = acc[ai][0][m][n][j], up = acc[ai][1][m][n][j]; o[n * 4 + j] = g * sigmoid_f(g) * up; }
                u32x4 w; w.x = cvt_pk_bf16(o[0], o[1]); w.y = cvt_pk_bf16(o[2], o[3]); w.z = cvt_pk_bf16(o[4], o[5]); w.w = cvt_pk_bf16(o[6], o[7]);
                *(u32x4*)(ACT + (size_t)(rowb + ai * HALF + m * 16) * ld + colb) = w;
            }
    }
};

template <class Epi, class Sched, bool ALIGN_EPI = false, bool SP2 = false>
__device__ __forceinline__ void gemm_phase(PG8_LAS unsigned char* lds, const Gemm g, const Sched& S, const Epi& E, const int wid) {
    const int lane = lane_id(), tid = wid * 64 + lane, wr = wid >> 2, wc = wid & 3, fr = lane & 15, fq = lane >> 4;
    const int K = g.K, nt = K / BK;
    unsigned voffA[2], voffB[2];
#pragma unroll
    for (int i = 0; i < 2; ++i) { int R, C; stage_rc(tid * 16 + i * 8192, R, C); const int Rb = Epi::PERM ? ((R & ~31) + perm32(R & 31)) : R;
        voffA[i] = (unsigned)(R * K + C) * 2u; voffB[i] = (unsigned)(Rb * K + C) * 2u; }
    const size_t kstep = (size_t)(BK * 2);
    const size_t hstep = (size_t)HALF * K * 2;
    const size_t tstep = 2 * hstep;
    const unsigned ldsw = (unsigned)wid * 1024u;
    const int aoff = lds_byte(wr * 64 + fr, fq * 8), boff = lds_byte(wc * 32 + fr, fq * 8);
#define PG8_SA(b, h) (((b) * 2 + (h)) * HTB)
#define PG8_SB(b, h) ((4 + (b) * 2 + (h)) * HTB)
#define PG8_STAGE(bufoff, gbase, voff) do { _Pragma("unroll") for (int _i = 0; _i < 2; ++_i) \
        __builtin_amdgcn_global_load_lds((const unsigned*)((const char*)(gbase) + (voff)[_i]), (PG8_LAS unsigned*)(lds + (bufoff) + ldsw + _i * 8192), 16, 0, 0); } while (0)
#define PG8_LDA(dst, b, h) do { _Pragma("unroll") for (int m = 0; m < 4; ++m) _Pragma("unroll") for (int k = 0; k < 2; ++k) dst[m][k] = *(const PG8_LAS bf16x8*)(lds + PG8_SA(b, h) + aoff + m * 2048 + k * 1024); } while (0)
#define PG8_LDB(dst, b, h) do { _Pragma("unroll") for (int n = 0; n < 2; ++n) _Pragma("unroll") for (int k = 0; k < 2; ++k) dst[n][k] = *(const PG8_LAS bf16x8*)(lds + PG8_SB(b, h) + boff + n * 2048 + k * 1024); } while (0)
#define PG8_MMA(ai, bj, At, Bt) do { __builtin_amdgcn_s_setprio(1); _Pragma("unroll") for (int m = 0; m < 4; ++m) _Pragma("unroll") for (int n = 0; n < 2; ++n) _Pragma("unroll") for (int k = 0; k < 2; ++k) \
        acc[ai][bj][m][n] = __builtin_amdgcn_mfma_f32_16x16x32_bf16(Bt[n][k], At[m][k], acc[ai][bj][m][n], 0, 0, 0); __builtin_amdgcn_s_setprio(0); } while (0)
#define PG8_WAIT_V(n) asm volatile("s_waitcnt vmcnt(" #n ")" ::: "memory")
#define PG8_WAIT_L(n) asm volatile("s_waitcnt lgkmcnt(" #n ")" ::: "memory")
#define PG8_BAR __builtin_amdgcn_s_barrier()
#define PG8_SCHED __builtin_amdgcn_sched_barrier(0)
    Unit cur, nxt; int ui = 0;
    if (!S.next(0, cur)) return;
    f32x4 acc[2][2][4][2];
#pragma unroll
    for (int a = 0; a < 2; ++a)
#pragma unroll
        for (int b = 0; b < 2; ++b)
#pragma unroll
            for (int m = 0; m < 4; ++m)
#pragma unroll
                for (int n = 0; n < 2; ++n) acc[a][b][m][n] = (f32x4){0.f, 0.f, 0.f, 0.f};
    bf16x8 At[4][2], B0[2][2], B1[2][2];
    const char* cA = (const char*)g.A + (size_t)cur.pm * tstep; const char* cB = (const char*)g.Bt + (size_t)cur.pn * tstep;
    S.a_ready(cur);
    if constexpr (SP2) {
        PG8_STAGE(PG8_SB(0, 0), cB, voffB); PG8_STAGE(PG8_SB(0, 1), cB + hstep, voffB); PG8_STAGE(PG8_SA(0, 0), cA, voffA); PG8_STAGE(PG8_SA(0, 1), cA + hstep, voffA);
        if (wr == 1) PG8_BAR;
        PG8_WAIT_V(2); PG8_BAR;
        PG8_STAGE(PG8_SB(1, 0), cB + kstep, voffB); PG8_STAGE(PG8_SA(1, 0), cA + kstep, voffA); PG8_STAGE(PG8_SB(1, 1), cB + hstep + kstep, voffB);
        PG8_WAIT_V(6); PG8_BAR;
    } else {
        PG8_STAGE(PG8_SB(0, 0), cB, voffB); PG8_STAGE(PG8_SA(0, 0), cA, voffA); PG8_STAGE(PG8_SB(0, 1), cB + hstep, voffB); PG8_STAGE(PG8_SA(0, 1), cA + hstep, voffA);
        if (wr == 1) PG8_BAR;
        PG8_WAIT_V(4); PG8_BAR;
        PG8_STAGE(PG8_SB(1, 0), cB + kstep, voffB); PG8_STAGE(PG8_SA(1, 0), cA + kstep, voffA); PG8_STAGE(PG8_SB(1, 1), cB + hstep + kstep, voffB);
        PG8_WAIT_V(6); PG8_BAR;
    }
    for (;;) {
        const bool has_next = S.next(ui + 1, nxt);
        const char* nA = has_next ? (const char*)g.A + (size_t)nxt.pm * tstep : cA; const char* nB = has_next ? (const char*)g.Bt + (size_t)nxt.pn * tstep : cB;
        for (int t = 0; t < nt; t += 2) {
            if constexpr (Epi::MID_T >= 0) { if (t == Epi::MID_T) E.mid(acc, cur, wr, wc, fr, fq); }
            const bool last = (t == nt - 2);
            const char* a1 = cA + (size_t)(t + 1) * kstep;
            const char* a2 = last ? nA : cA + (size_t)(t + 2) * kstep; const char* b2 = last ? nB : cB + (size_t)(t + 2) * kstep;
            const char* a3 = a2 + kstep; const char* b3 = b2 + kstep;
            if (last && has_next) S.a_ready(nxt);
            if constexpr (SP2) {
            PG8_LDB(B0, 0, 0); PG8_LDB(B1, 0, 1); PG8_SCHED; PG8_LDA(At, 0, 0); PG8_STAGE(PG8_SA(1, 1), a1 + hstep, voffA);
            PG8_WAIT_V(8); PG8_WAIT_L(0); PG8_BAR; PG8_MMA(0, 0, At, B0); PG8_MMA(0, 1, At, B1); PG8_BAR; PG8_SCHED;
            PG8_LDA(At, 0, 1); PG8_STAGE(PG8_SB(0, 0), b2, voffB); PG8_STAGE(PG8_SB(0, 1), b2 + hstep, voffB); PG8_STAGE(PG8_SA(0, 0), a2, voffA);
            PG8_WAIT_V(8); PG8_WAIT_L(0); PG8_BAR; PG8_MMA(1, 0, At, B0); PG8_MMA(1, 1, At, B1); PG8_BAR; PG8_SCHED;
            PG8_LDB(B0, 1, 0); PG8_LDB(B1, 1, 1); PG8_SCHED; PG8_LDA(At, 1, 0); PG8_STAGE(PG8_SA(0, 1), a2 + hstep, voffA);
            PG8_WAIT_V(8); PG8_WAIT_L(0); PG8_BAR; PG8_MMA(0, 0, At, B0); PG8_MMA(0, 1, At, B1); PG8_BAR; PG8_SCHED;
            PG8_LDA(At, 1, 1); PG8_STAGE(PG8_SB(1, 0), b3, voffB); PG8_STAGE(PG8_SB(1, 1), b3 + hstep, voffB); PG8_STAGE(PG8_SA(1, 0), a3, voffA);
            PG8_WAIT_V(8); PG8_WAIT_L(0); PG8_BAR; PG8_MMA(1, 0, At, B0); PG8_MMA(1, 1, At, B1); PG8_BAR; PG8_SCHED;
            } else {
            PG8_LDB(B0, 0, 0); PG8_SCHED; PG8_LDA(At, 0, 0); PG8_STAGE(PG8_SA(1, 1), a1 + hstep, voffA);
            PG8_WAIT_L(8); PG8_BAR; PG8_WAIT_L(0); PG8_MMA(0, 0, At, B0); PG8_BAR; PG8_SCHED;
            PG8_LDB(B1, 0, 1); PG8_STAGE(PG8_SB(0, 0), b2, voffB);
            PG8_BAR; PG8_WAIT_L(0); PG8_MMA(0, 1, At, B1); PG8_BAR;
            PG8_LDA(At, 0, 1); PG8_STAGE(PG8_SA(0, 0), a2, voffA);
            PG8_BAR; PG8_WAIT_L(0); PG8_MMA(1, 0, At, B0); PG8_BAR; PG8_SCHED;
            PG8_STAGE(PG8_SB(0, 1), b2 + hstep, voffB);
            PG8_WAIT_V(6); PG8_BAR; PG8_MMA(1, 1, At, B1); PG8_BAR;
            PG8_LDB(B0, 1, 0); PG8_SCHED; PG8_LDA(At, 1, 0); PG8_STAGE(PG8_SA(0, 1), a2 + hstep, voffA);
            PG8_WAIT_L(8); PG8_BAR; PG8_WAIT_L(0); PG8_MMA(0, 0, At, B0); PG8_BAR; PG8_SCHED;
            PG8_LDB(B1, 1, 1); PG8_STAGE(PG8_SB(1, 0), b3, voffB);
            PG8_BAR; PG8_WAIT_L(0); PG8_MMA(0, 1, At, B1); PG8_BAR;
            PG8_LDA(At, 1, 1); PG8_STAGE(PG8_SA(1, 0), a3, voffA);
            PG8_BAR; PG8_WAIT_L(0); PG8_MMA(1, 0, At, B0); PG8_BAR; PG8_SCHED;
            PG8_STAGE(PG8_SB(1, 1), b3 + hstep, voffB);
            PG8_WAIT_V(6); PG8_BAR; PG8_MMA(1, 1, At, B1); PG8_BAR;
            }
        }
        if constexpr (ALIGN_EPI) { if (wr == 0) PG8_BAR; }
        if constexpr (!Epi::AFTER_DRAIN) { E(acc, cur, wr, wc, fr, fq); S.done(cur); }
        if (!has_next) break;
#pragma unroll
        for (int a = 0; a < 2; ++a)
#pragma unroll
            for (int b = 0; b < 2; ++b)
#pragma unroll
                for (int m = 0; m < 4; ++m)
#pragma unroll
                    for (int n = 0; n < 2; ++n) acc[a][b][m][n] = (f32x4){0.f, 0.f, 0.f, 0.f};
        cur = nxt; cA = nA; cB = nB; ++ui;
        if constexpr (ALIGN_EPI) { if (wr == 1) PG8_BAR; }
    }
    PG8_WAIT_V(0);
    if constexpr (!ALIGN_EPI) { if (wr == 0) PG8_BAR; }
    PG8_BAR;
    if constexpr (Epi::AFTER_DRAIN) { E.fused(acc, cur, wr, wc, fr, fq, lds, wid, lane); S.done(cur); }
#undef PG8_SA
#undef PG8_SB
#undef PG8_STAGE
#undef PG8_LDA
#undef PG8_LDB
#undef PG8_MMA
#undef PG8_WAIT_V
#undef PG8_WAIT_L
#undef PG8_BAR
#undef PG8_SCHED
}
}


constexpr int NWAVES = 8, NTHR = NWAVES * 64;
#ifndef MK_N_LAUNCHES
#define MK_N_LAUNCHES 1
#endif
constexpr int N_PHASES = 10;
constexpr int N_LAUNCHES = MK_N_LAUNCHES;
constexpr int DM = 1024, M_CTX = pg8::M_CTX, L_CTX = 256, B_CTX = 16, M_LAT = 8192, L_LAT = 2048, B_LAT = 4, M = M_CTX + M_LAT;
constexpr int NHEAD = 8, NKV = 2, HD = 128, KVW = 256, HYW = 512, NIN = 3072 + 2048, KMIX = 1024 + 512, DFF = 2816, NUP = 2 * DFF;
constexpr int NMOD = 6 * DM, MOD_KS = 16;
constexpr float EPS = 1e-6f;
constexpr int OUT_Y = 0, OUT_NEWK = M * DM, OUT_NEWV = OUT_NEWK + M_CTX * KVW;

constexpr size_t MiB = 1u << 20;
constexpr size_t WS_CTL = 0, CTL_ZERO_BYTES = 1 * MiB;
constexpr size_t WS_W1 = 2 * MiB;
constexpr size_t WS_W2 = 12 * MiB;
constexpr size_t WS_W3 = 15 * MiB;
constexpr size_t WS_W4 = 17 * MiB;
constexpr size_t WS_W5 = 28 * MiB;
constexpr size_t WS_MODP = 34 * MiB;
constexpr size_t WS_MOD = 36 * MiB;
constexpr size_t WS_ROPE = 36 * MiB + 256 * 1024;
constexpr size_t WS_CK = 37 * MiB;
constexpr size_t WS_CV = 37 * MiB + 512 * 1024;
constexpr size_t WS_FSL = 38 * MiB;
constexpr size_t WS_FSC = 46 * MiB;
constexpr size_t WS_HL = 228 * MiB;
constexpr size_t WS_HC = 244 * MiB;
constexpr size_t WS_XN = 48 * MiB;
constexpr size_t WS_Q = 72 * MiB;
constexpr size_t WS_K = 96 * MiB;
constexpr size_t WS_V = 102 * MiB;
constexpr size_t WS_HY = 108 * MiB;
constexpr size_t WS_GT = 144 * MiB;
constexpr size_t WS_AH = 192 * MiB;
constexpr size_t WS_MG = 72 * MiB;
constexpr size_t WS_ACT = 72 * MiB;
constexpr size_t WS_F32 = 144 * MiB;
constexpr size_t WS_END = 252 * MiB;
static_assert(WS_ACT + (size_t)M * DFF * 2 <= WS_GT && WS_F32 + (size_t)M * DM * 4 <= WS_AH && WS_MG + (size_t)M * DM * 2 <= WS_K && WS_HC + 2 * MiB <= WS_END && WS_FSC + MiB <= WS_XN, "d_ws map");
constexpr int CW_TMO = 0, CW_CODE = 1, CW_BAR = 4096;

constexpr int RING_OFF = 0, RING_BYTES = 131072;
constexpr int LDSCTL_OFF = RING_BYTES, MISC_OFF = LDSCTL_OFF + 320;
constexpr int LDS_BYTES = 147456;
static_assert(MISC_OFF + 128 <= LDS_BYTES, "LDS map");

#define GAS __attribute__((address_space(1)))
#define LAS __attribute__((address_space(3)))
typedef unsigned short bf16;
typedef unsigned v4u __attribute__((ext_vector_type(4)));
typedef unsigned v2u __attribute__((ext_vector_type(2)));
typedef float f32x4 __attribute__((ext_vector_type(4)));
typedef GAS unsigned gu32;
#define RLX_AGENT __ATOMIC_RELAXED, __HIP_MEMORY_SCOPE_AGENT
#define LDS_WAIT() asm volatile("s_waitcnt lgkmcnt(0)" ::: "memory")
#define VM_WAIT() asm volatile("s_waitcnt vmcnt(0)" ::: "memory")
__device__ __forceinline__ unsigned f2bf(float f) { unsigned u = __builtin_bit_cast(unsigned, f); return (u + 0x7fffu + ((u >> 16) & 1u)) >> 16; }
__device__ __forceinline__ unsigned pk2(float lo, float hi) { return f2bf(lo) | (f2bf(hi) << 16); }
__device__ __forceinline__ float bf2f(bf16 v) { return __uint_as_float((unsigned)v << 16); }
__device__ __forceinline__ float wave_sum(float v) {
#pragma unroll
    for (int o = 1; o < 64; o <<= 1) v += __shfl_xor(v, o);
    return v;
}
__device__ __forceinline__ float wave_max(float v) {
#pragma unroll
    for (int o = 1; o < 64; o <<= 1) v = fmaxf(v, __shfl_xor(v, o));
    return v;
}

#define XB_TMO      128
#define XB_XCNT(j)  (256  + 64 * (j))
#define XB_XSUB(j)  (1280 + 64 * (j))
#define XB_XGEN(j)  (2304 + 64 * (j))
#define XB_TOP      3328
#define XB_TOPGEN   3392
#define XCD_BAR_WORDS 3456
#define XB_SPIN_CAP (1u << 18)

__device__ __forceinline__ unsigned xb_ld(unsigned* p)              { return __hip_atomic_load(p, __ATOMIC_RELAXED, __HIP_MEMORY_SCOPE_AGENT); }
__device__ __forceinline__ unsigned xb_add(unsigned* p, unsigned v) { return __hip_atomic_fetch_add(p, v, __ATOMIC_RELAXED, __HIP_MEMORY_SCOPE_AGENT); }
__device__ __forceinline__ unsigned xb_xcc_id() { return (unsigned)__builtin_amdgcn_s_getreg((3 << 11) | 20) & 0xFu; }
#define XB_SPIN(cond, bar) do { unsigned _sp = 0; while (cond) { __builtin_amdgcn_s_sleep(1); \
    if ((++_sp & 255u) == 0u) { if (xb_ld(&(bar)[XB_TMO])) break; if (_sp > XB_SPIN_CAP) { atomicAdd(&(bar)[XB_TMO], 1u); break; } } } } while (0)

struct XcdBarrier {
    unsigned* bar; unsigned x;
    volatile LAS unsigned* st;
};

__device__ __forceinline__ XcdBarrier xcd_barrier_post(unsigned* bar, volatile LAS unsigned* st, int wave) {
    XcdBarrier b; b.bar = bar; b.x = xb_xcc_id(); b.st = st;
    if (wave == 0 && lane_id() == 0) (void)xb_add(&bar[XB_XCNT(b.x)], 1u);
    return b;
}
__device__ __forceinline__ void xcd_barrier_complete(unsigned* bar, unsigned x, unsigned& nloc, unsigned& nx) {
    const unsigned G = gridDim.x * gridDim.y * gridDim.z;
    unsigned sum, cnt, mine, sp = 0u;
    for (;;) {
        sum = 0u; cnt = 0u; mine = 0u;
#pragma unroll
        for (unsigned j = 0; j < 16; ++j) { const unsigned c = xb_ld(&bar[XB_XCNT(j)]); sum += c; cnt += (c > 0u) ? 1u : 0u; mine = (j == x) ? c : mine; }
        if (sum == G) break;
        __builtin_amdgcn_s_sleep(1);
        if ((++sp & 255u) == 0u) { if (xb_ld(&bar[XB_TMO])) break; if (sp > XB_SPIN_CAP) { atomicAdd(&bar[XB_TMO], 1u); break; } }
    }
    nloc = mine > 0u ? mine : 1u; nx = cnt > 0u ? cnt : 1u;
}

__device__ __forceinline__ void xcd_barrier(const XcdBarrier& b, int wave) {
    asm volatile("s_waitcnt vmcnt(0)" ::: "memory");
    __syncthreads();
    if (wave == 0 && lane_id() == 0) {
        unsigned* bar = b.bar;
        __builtin_amdgcn_s_waitcnt(0);
        unsigned nloc = b.st[0], nx = b.st[1];
        if (nloc == 0u) { xcd_barrier_complete(bar, b.x, nloc, nx); b.st[0] = nloc; b.st[1] = nx; }
        const unsigned old = xb_add(&bar[XB_XSUB(b.x)], 1u);
        const unsigned gen = old / nloc;
        if (old + 1u == (gen + 1u) * nloc) {
            __builtin_amdgcn_fence(__ATOMIC_RELEASE, "agent");
            asm volatile("s_waitcnt vmcnt(0)" ::: "memory");
            const unsigned og = xb_add(&bar[XB_TOP], 1u);
            const unsigned tg = og / nx;
            if (og + 1u == (tg + 1u) * nx) xb_add(&bar[XB_TOPGEN], 1u);
            else XB_SPIN(xb_ld(&bar[XB_TOPGEN]) == tg, bar);
            __builtin_amdgcn_fence(__ATOMIC_ACQUIRE, "agent");
            xb_add(&bar[XB_XGEN(b.x)], 1u);
            asm volatile("s_waitcnt vmcnt(0)" ::: "memory");
        } else {
            XB_SPIN(xb_ld(&bar[XB_XGEN(b.x)]) == gen, bar);
            __builtin_amdgcn_fence(__ATOMIC_ACQUIRE, "agent");
            asm volatile("s_waitcnt vmcnt(0)" ::: "memory");
        }
    }
    __syncthreads();
}

struct Args { const float* in[33]; float* out; unsigned char* ws; int ph_lo, ph_hi, li, pad; };
struct Frame {
    LAS unsigned char* lds;
    volatile LAS unsigned* MISC;
    gu32* ctl;
    int wave;
    int vcu, G;
    float* out; unsigned char* ws;
};
typedef const float* const __attribute__((address_space(4))) * kargp_t;
__device__ __forceinline__ const float* inp(int i) { return ((kargp_t)__builtin_amdgcn_kernarg_segment_ptr())[i]; }
enum { I_XP = 0, I_XS, I_C, I_CK, I_CV, I_CCTX, I_NMPRE, I_NMPOST, I_NFPRE, I_NFPOST, I_WMOD, I_BMOD, I_WIN, I_SINK, I_CONVW, I_CONVB,
       I_FW1, I_FB1, I_FFR1, I_FW2, I_FB2, I_FFR2, I_FW3, I_FB3, I_FDEC, I_SKIP, I_WPA, I_WPH, I_WGATE, I_BGATE, I_WO, I_WUP, I_WDOWN };

__device__ __forceinline__ const float* xrow_ptr(const Args& A, int m) { return m < M_CTX ? inp(I_XP) + (size_t)m * DM : inp(I_XS) + (size_t)(m - M_CTX) * DM; }
__device__ __forceinline__ int mod_row(int m) { return m < M_CTX ? 0 : 1 + ((m - M_CTX) >> 11); }

template <class Map>
__device__ __forceinline__ void p0_transpose_item(const float* W, int K, int N, bf16* WT, int ldk, int koff, Map map, LAS float* scr, int item, int lane) {
    const int nblk = N / 32, kb = item / nblk, nb = item % nblk, k0 = 64 * kb, n0 = 32 * nb;
#pragma unroll 8
    for (int i = 0; i < 32; ++i) { const int kk = 2 * i + (lane >> 5); scr[kk * 33 + (lane & 31)] = W[(size_t)(k0 + kk) * N + n0 + (lane & 31)]; }
    LDS_WAIT(); asm volatile("" ::: "memory");
    const int c = lane & 7;
#pragma unroll
    for (int j = 0; j < 4; ++j) { const int n = (lane >> 3) + 8 * j; const LAS float* s = scr + (8 * c) * 33 + n;
        v4u o; o.x = pk2(s[0 * 33], s[1 * 33]); o.y = pk2(s[2 * 33], s[3 * 33]); o.z = pk2(s[4 * 33], s[5 * 33]); o.w = pk2(s[6 * 33], s[7 * 33]);
        *(GAS v4u*)(WT + (size_t)map(n0 + n) * ldk + koff + k0 + 8 * c) = o; }
    LDS_WAIT(); asm volatile("" ::: "memory");
}
struct MapIn {
    __device__ __forceinline__ int operator()(int n) const {
        if (n >= 1280) return n;
        const int d = n & 127, half = d >> 6, r = d & 63, nn = r >> 5, q = r & 31, idx8 = q >> 2, j = q & 3, wc = half * 2 + (idx8 >> 2), fq = idx8 & 3;
        return (n & ~127) + 32 * wc + 8 * fq + 4 * nn + j; }
};
struct MapOff { int off; __device__ __forceinline__ int operator()(int n) const { return n + off; } };
struct MapUp {
    __device__ __forceinline__ int operator()(int n) const { const int up = n >= DFF ? 1 : 0, i = n - up * DFF; return (i >> 7) * 256 + up * 128 + (i & 127); }
};

__device__ __forceinline__ float silu_f(float x) { return x / (1.0f + __expf(-x)); }

__device__ __forceinline__ void p0_filter_item(const Frame& F, const Args& A, int t, int L, float* FS, int lane) {
    const float tn = (float)t / (float)L;
    const float base = (6.283185307179586f * (float)t) / (float)L;
    float s = inp(I_FB1)[lane] + tn * inp(I_FW1)[lane];
#pragma unroll
    for (int i = 0; i < 8; ++i) { const float band = 1e-4f + (float)i * ((7.0f - 1e-4f) / 7.0f); const float ang = base * band;
        s += cosf(ang) * inp(I_FW1)[(1 + i) * 64 + lane] + sinf(ang) * inp(I_FW1)[(9 + i) * 64 + lane]; }
    const float h1 = sinf(inp(I_FFR1)[lane] * s);
    float s2 = inp(I_FB2)[lane];
#pragma unroll 8
    for (int j = 0; j < 64; ++j) s2 += __shfl(h1, j) * inp(I_FW2)[j * 64 + lane];
    const float h2 = sinf(inp(I_FFR2)[lane] * s2);
    float acc[16];
#pragma unroll
    for (int cc = 0; cc < 16; ++cc) acc[cc] = inp(I_FB3)[cc * 64 + lane];
    for (int j = 0; j < 64; ++j) { const float hj = __shfl(h2, j); const float* w = inp(I_FW3) + (size_t)j * 1024 + lane;
#pragma unroll
        for (int cc = 0; cc < 16; ++cc) acc[cc] += hj * w[cc * 64]; }
#pragma unroll
    for (int cc = 0; cc < 16; ++cc) { const int col = cc * 64 + lane; const float v = acc[cc] * __expf(-tn * fabsf(inp(I_FDEC)[col]));
        if (cc < 8) FS[(size_t)col * (2 * L) + t] = v;
        else FS[(size_t)(col - 512) * (2 * L) + (t == 0 ? L : 2 * L - t)] = (t == 0) ? 0.f : v; }

}

__device__ __forceinline__ void p0_prologue(Frame& F, const Args& A) {
    const int L_lane = lane_id();
    LAS float* scr = (LAS float*)(F.lds + RING_OFF + F.wave * 16384);
    const int gw = F.vcu * NWAVES + F.wave, NGW = F.G * NWAVES, lane = L_lane;
    bf16* W1 = (bf16*)(F.ws + WS_W1); bf16* W2 = (bf16*)(F.ws + WS_W2); bf16* W3 = (bf16*)(F.ws + WS_W3); bf16* W4 = (bf16*)(F.ws + WS_W4); bf16* W5 = (bf16*)(F.ws + WS_W5);
    constexpr int N_FILT = L_CTX + L_LAT;
    constexpr int T_IN = (DM / 64) * (3072 / 32), T_GATE = (DM / 64) * (2048 / 32), T_PA = (DM / 64) * (DM / 32), T_PH = (HYW / 64) * (DM / 32), T_O = T_PA,
                  T_UP = (DM / 64) * (NUP / 32), T_DOWN = (DFF / 64) * (DM / 32);
    constexpr int N_MODI = (NMOD / 256) * MOD_KS, N_ROPE = 32, N_CACHE = 2 * (B_LAT * 256 * KVW) / 512;
    constexpr int NITEMS = N_FILT + T_IN + T_GATE + T_PA + T_PH + T_O + T_UP + T_DOWN + N_MODI + N_ROPE + N_CACHE;
    for (int it = gw; it < NITEMS; it += NGW) {
        int r = it;
        if (r < N_FILT) { if (r < L_LAT) p0_filter_item(F, A, r, L_LAT, (float*)(F.ws + WS_FSL), lane); else p0_filter_item(F, A, r - L_LAT, L_CTX, (float*)(F.ws + WS_FSC), lane); continue; } r -= N_FILT;
        if (r < T_IN) { p0_transpose_item(inp(I_WIN), DM, 3072, W1, DM, 0, MapIn{}, scr, r, lane); continue; } r -= T_IN;
        if (r < T_GATE) { p0_transpose_item(inp(I_WGATE), DM, 2048, W1, DM, 0, MapOff{3072}, scr, r, lane); continue; } r -= T_GATE;
        if (r < T_PA) { p0_transpose_item(inp(I_WPA), DM, DM, W2, KMIX, 0, MapOff{0}, scr, r, lane); continue; } r -= T_PA;
        if (r < T_PH) { p0_transpose_item(inp(I_WPH), HYW, DM, W2, KMIX, DM, MapOff{0}, scr, r, lane); continue; } r -= T_PH;
        if (r < T_O) { p0_transpose_item(inp(I_WO), DM, DM, W3, DM, 0, MapOff{0}, scr, r, lane); continue; } r -= T_O;
        if (r < T_UP) { p0_transpose_item(inp(I_WUP), DM, NUP, W4, DM, 0, MapUp{}, scr, r, lane); continue; } r -= T_UP;
        if (r < T_DOWN) { p0_transpose_item(inp(I_WDOWN), DFF, DM, W5, DFF, 0, MapOff{0}, scr, r, lane); continue; } r -= T_DOWN;
        if (r < N_MODI) {
            const int cg = r / MOD_KS, ks = r % MOD_KS, col = cg * 256 + lane * 4;
            f32x4 acc[5];
#pragma unroll
            for (int q = 0; q < 5; ++q) acc[q] = (f32x4){0.f, 0.f, 0.f, 0.f};
            for (int k = ks * 64; k < ks * 64 + 64; ++k) {
                const f32x4 w = *(const f32x4*)(inp(I_WMOD) + (size_t)k * NMOD + col);
                acc[0] += silu_f(inp(I_CCTX)[k]) * w;
#pragma unroll
                for (int q = 1; q < 5; ++q) acc[q] += silu_f(inp(I_C)[(q - 1) * DM + k]) * w;
            }
            float* mp = (float*)(F.ws + WS_MODP) + (size_t)ks * 5 * NMOD + col;
#pragma unroll
            for (int q = 0; q < 5; ++q) *(f32x4*)(mp + q * NMOD) = acc[q];
            continue; } r -= N_MODI;
        if (r < N_ROPE) {
            const int pos = 2 * r + (lane >> 5), f = lane & 31;
            const float inv = expf(-(float)f * (9.210340371976184f / 32.0f));
            const float ang = (float)pos * inv;
            float* rp = (float*)(F.ws + WS_ROPE) + (size_t)(pos * 32 + f) * 2; rp[0] = cosf(ang); rp[1] = sinf(ang);
            continue; } r -= N_ROPE;
        {
            const int half = (B_LAT * 256 * KVW) / 512; const bool isv = r >= half; const int idx = (isv ? r - half : r) * 512 + lane * 8;
            const float* src = (isv ? inp(I_CV) : inp(I_CK)) + idx; bf16* dst = (bf16*)(F.ws + (isv ? WS_CV : WS_CK)) + idx;
            const f32x4 a = *(const f32x4*)src, b = *(const f32x4*)(src + 4);
            v4u o; o.x = pk2(a.x, a.y); o.y = pk2(a.z, a.w); o.z = pk2(b.x, b.y); o.w = pk2(b.z, b.w); *(v4u*)dst = o;
        }
    }
}

__device__ __forceinline__ float mod_total(const Frame& F, const Args& A, int r, int col) {
    const float* mp = (const float*)(F.ws + WS_MODP) + (size_t)r * NMOD + col; float s = inp(I_BMOD)[col];
#pragma unroll
    for (int ks = 0; ks < MOD_KS; ++ks) s += mp[(size_t)ks * 5 * NMOD];
    return s;
}
__device__ __forceinline__ void p1_rows(Frame& F, const Args& A) {
    const int L_lane = lane_id(), L_tid = F.wave * 64 + L_lane;
    if (F.vcu < 30) {
        const int r = F.vcu / 6, c0 = (F.vcu % 6) * 1024;
        for (int i = L_tid; i < 1024; i += NTHR) ((float*)(F.ws + WS_MOD))[r * NMOD + c0 + i] = mod_total(F, A, r, c0 + i);
    }
    LAS float* vA = (LAS float*)(F.lds + RING_OFF); LAS float* vB = vA + DM;
    int cur = -1;
    bf16* XN = (bf16*)(F.ws + WS_XN);
    for (int ch = 0; ch < 3; ++ch) {
        const int row0 = F.vcu * 48 + ch * 16;
        if (row0 >= M) break;
        const int r = mod_row(row0);
        if (r != cur) {
            __syncthreads();
            for (int i = L_tid; i < DM; i += NTHR) { vA[i] = inp(I_NMPRE)[i] * (1.0f + mod_total(F, A, r, DM + i)); vB[i] = mod_total(F, A, r, i); }
            __syncthreads(); cur = r;
        }
#pragma unroll 1
        for (int q = 0; q < 2; ++q) {
            const int m = row0 + F.wave * 2 + q;
            const f32x4* xr = (const f32x4*)xrow_ptr(A, m) + L_lane;
            f32x4 v[4]; float s = 0.f;
#pragma unroll
            for (int j = 0; j < 4; ++j) { v[j] = xr[64 * j]; s += (v[j].x * v[j].x + v[j].y * v[j].y) + (v[j].z * v[j].z + v[j].w * v[j].w); }
            const float rstd = 1.0f / sqrtf(wave_sum(s) * (1.0f / DM) + EPS);
            unsigned long long* o8 = (unsigned long long*)(XN + (size_t)m * DM) + L_lane;
#pragma unroll
            for (int j = 0; j < 4; ++j) { const int c = 4 * L_lane + 256 * j;
                const float a = v[j].x * rstd * vA[c] + vB[c], b = v[j].y * rstd * vA[c + 1] + vB[c + 1], cc = v[j].z * rstd * vA[c + 2] + vB[c + 2], d = v[j].w * rstd * vA[c + 3] + vB[c + 3];
                o8[64 * j] = (unsigned long long)pk2(a, b) | ((unsigned long long)pk2(cc, d) << 32); }
        }
    }
}


namespace att {
using bf16x8 = __attribute__((ext_vector_type(8))) short;
using s16x4  = __attribute__((ext_vector_type(4))) short;
using f32x16 = __attribute__((ext_vector_type(16))) float;
using u32x4  = __attribute__((ext_vector_type(4))) unsigned;
constexpr int D = 128, NW = 8, QBLK = 32, KVBLK = 64, LDKV = 256;
constexpr int SHM_V = KVBLK * D * 2, SHM_K = KVBLK * D * 2, SHM_ATTN = 2 * SHM_V + 2 * SHM_K + NW * 64 * 4;
constexpr float THR2 = 8.0f;
#define KSWZ(row, colB) ((row) * 256 + ((colB) ^ (((row) & 7) << 4)))
#define SBAR() __builtin_amdgcn_sched_barrier(0)
__device__ __forceinline__ int crow(int r, int hi) { return (r & 3) + 8 * (r >> 2) + 4 * hi; }
__device__ __forceinline__ unsigned cvtpk(float lo, float hi) { unsigned r; asm volatile("v_cvt_pk_bf16_f32 %0, %1, %2" : "=v"(r) : "v"(lo), "v"(hi)); return r; }
__device__ __forceinline__ void partialSM(f32x16& p0, f32x16& p1, float& m_reg, float& mn, float& alpha) {
  float pmax = p0[0];
#pragma unroll
  for (int r = 1; r < 16; ++r) pmax = fmaxf(pmax, p0[r]);
#pragma unroll
  for (int r = 0; r < 16; ++r) pmax = fmaxf(pmax, p1[r]);
  { auto rr = __builtin_amdgcn_permlane32_swap(__float_as_uint(pmax), __float_as_uint(pmax), false, false);
    pmax = fmaxf(__uint_as_float(rr[0]), __uint_as_float(rr[1])); }
  if (__builtin_expect(__all(pmax - m_reg <= THR2), 1)) { mn = m_reg; alpha = 1.f; }
  else { mn = fmaxf(m_reg, pmax); alpha = __builtin_amdgcn_exp2f(m_reg - mn); m_reg = mn; }
#pragma unroll
  for (int r = 0; r < 16; ++r) p0[r] = p0[r] - mn;
#pragma unroll
  for (int r = 0; r < 16; ++r) p1[r] = p1[r] - mn;
#pragma unroll
  for (int r = 0; r < 16; ++r) p0[r] = __builtin_amdgcn_exp2f(p0[r]);
}
__device__ __forceinline__ void finishSM(f32x16& p0, f32x16& p1, float alpha, float& l_reg, bf16x8& pa0, bf16x8& pa1, bf16x8& pa2, bf16x8& pa3) {
#pragma unroll
  for (int r = 0; r < 16; ++r) p1[r] = __builtin_amdgcn_exp2f(p1[r]);
  float ps = 0;
#pragma unroll
  for (int r = 0; r < 16; ++r) ps += p0[r];
#pragma unroll
  for (int r = 0; r < 16; ++r) ps += p1[r];
  { auto rr = __builtin_amdgcn_permlane32_swap(__float_as_uint(ps), __float_as_uint(ps), false, false);
    ps = __uint_as_float(rr[0]) + __uint_as_float(rr[1]); }
  l_reg = l_reg * alpha + ps;
#define PK4(P, BASE, OUT) do { unsigned a0 = cvtpk(P[BASE + 0], P[BASE + 1]), a1 = cvtpk(P[BASE + 2], P[BASE + 3]);   \
    unsigned b0 = cvtpk(P[BASE + 4], P[BASE + 5]), b1 = cvtpk(P[BASE + 6], P[BASE + 7]);                              \
    auto r0 = __builtin_amdgcn_permlane32_swap(a0, b0, false, false); auto r1 = __builtin_amdgcn_permlane32_swap(a1, b1, false, false); \
    u32x4 w = {r0[0], r1[0], r0[1], r1[1]}; OUT = *reinterpret_cast<bf16x8*>(&w); } while (0)
  PK4(p0, 0, pa0); PK4(p0, 8, pa1); PK4(p1, 0, pa2); PK4(p1, 8, pa3);
#undef PK4
}
__device__ __forceinline__ void qkt(f32x16& p0, f32x16& p1, const LAS char* Ks, const bf16x8* qr, int r32, int hi) {
  p0 = f32x16{}; p1 = f32x16{};
#pragma unroll
  for (int d0 = 0; d0 < 8; ++d0) { int cb = (d0 * 16 + hi * 8) * 2;
    bf16x8 b0 = *reinterpret_cast<const LAS bf16x8*>(Ks + KSWZ(r32, cb));
    bf16x8 b1 = *reinterpret_cast<const LAS bf16x8*>(Ks + KSWZ(32 + r32, cb));
    p0 = __builtin_amdgcn_mfma_f32_32x32x16_bf16(b0, qr[d0], p0, 0, 0, 0);
    p1 = __builtin_amdgcn_mfma_f32_32x32x16_bf16(b1, qr[d0], p1, 0, 0, 0); }
}
__device__ __forceinline__ void wmask(f32x16& p0, f32x16& p1, int kd, int hi) {
  const int b = kd + 4 * hi;
#pragma unroll
  for (int r = 0; r < 16; ++r) { const int d = b + (r & 3) + 8 * (r >> 2);
    if (d > 128 || d < -128) p0[r] = -1e30f;
    if (d + 32 > 128 || d + 32 < -128) p1[r] = -1e30f; }
}
__device__ __forceinline__ int v_st(int k, int c) { const int kk = (k & ~0xC) | ((k & 4) << 1) | ((k & 8) >> 1); return ((kk >> 3) * 4 + (c >> 5)) * 512 + ((kk & 7) * 32 + (c & 31)) * 2; }
__device__ __forceinline__ int v_rd_base(int lane) { return ((lane & 3) << 3) | (((lane >> 2) & 3) << 6) | (((lane >> 4) & 1) << 5) | (((lane >> 5) & 1) << 8); }
constexpr int v_rd_off(int d0, int ks, int half) { return d0 * 512 + ks * 4096 + half * 2048; }
template <int OFF> __device__ __forceinline__ s16x4 tr_read(int vb) {
  s16x4 r; asm volatile("ds_read_b64_tr_b16 %0, %1 offset:%2" : "=&v"(r) : "v"(vb), "i"(OFF) : "memory"); return r;
}
template <int D0> __device__ __forceinline__ void pv_one(f32x16& od, int vb, bf16x8 pa0, bf16x8 pa1, bf16x8 pa2, bf16x8 pa3) {
  const s16x4 l0 = tr_read<v_rd_off(D0, 0, 0)>(vb), h0 = tr_read<v_rd_off(D0, 0, 1)>(vb), l1 = tr_read<v_rd_off(D0, 1, 0)>(vb), h1 = tr_read<v_rd_off(D0, 1, 1)>(vb);
  const s16x4 l2 = tr_read<v_rd_off(D0, 2, 0)>(vb), h2 = tr_read<v_rd_off(D0, 2, 1)>(vb), l3 = tr_read<v_rd_off(D0, 3, 0)>(vb), h3 = tr_read<v_rd_off(D0, 3, 1)>(vb);
  asm volatile("s_waitcnt lgkmcnt(0)" ::: "memory"); SBAR();
#define PK(L, H) (bf16x8){L[0], L[1], L[2], L[3], H[0], H[1], H[2], H[3]}
  od = __builtin_amdgcn_mfma_f32_32x32x16_bf16(pa0, PK(l0, h0), od, 0, 0, 0);
  od = __builtin_amdgcn_mfma_f32_32x32x16_bf16(pa1, PK(l1, h1), od, 0, 0, 0);
  od = __builtin_amdgcn_mfma_f32_32x32x16_bf16(pa2, PK(l2, h2), od, 0, 0, 0);
  od = __builtin_amdgcn_mfma_f32_32x32x16_bf16(pa3, PK(l3, h3), od, 0, 0, 0);
#undef PK
}
__device__ __forceinline__ void pv_d0(f32x16* o, int vb, bf16x8 pa0, bf16x8 pa1, bf16x8 pa2, bf16x8 pa3) {
  pv_one<0>(o[0], vb, pa0, pa1, pa2, pa3); pv_one<1>(o[1], vb, pa0, pa1, pa2, pa3); pv_one<2>(o[2], vb, pa0, pa1, pa2, pa3); pv_one<3>(o[3], vb, pa0, pa1, pa2, pa3);
}
__device__ __forceinline__ void attn_item(const bf16* Qw, const bf16* Kw, const bf16* Vw, const bf16* Kc, const bf16* Vc, int nwt, int NT, bool masked, int qrel,
                                          float sinkl, bf16* Ow, LAS char* lds, int wid, int lane) {
  const int tid = wid * 64 + lane, r32 = lane & 31, hi = lane >> 5;
  LAS char* V_lds = lds; LAS char* K_lds = lds + 2 * SHM_V;
  LAS float* ws = (LAS float*)(lds + 2 * SHM_V + 2 * SHM_K) + wid * 64; LAS float* li_l = ws; LAS float* al_l = ws + 32;
  float m_reg = sinkl, l_reg = 1.0f; f32x16 o[4] = {}; bf16x8 qr[8];
  const bf16* Qp = Qw + (long)r32 * 1024 + hi * 8;
#pragma unroll
  for (int d0 = 0; d0 < 8; ++d0) qr[d0] = *reinterpret_cast<const bf16x8*>(Qp + d0 * 16);
  const int sr = tid >> 4, sc = (tid & 15) * 8, vst0 = v_st(sr, sc), vst1 = v_st(32 + sr, sc);
  const int vb0 = (int)(uintptr_t)V_lds + v_rd_base(lane);
  const int qd = qrel + r32;
  struct { bf16x8 vs0, vs1, ks0, ks1; } sr_[2];
#define TK(t) (((t) < nwt) ? Kw + (long)(t) * KVBLK * LDKV : Kc + (long)((t) - nwt) * KVBLK * LDKV)
#define TV(t) (((t) < nwt) ? Vw + (long)(t) * KVBLK * LDKV : Vc + (long)((t) - nwt) * KVBLK * LDKV)
#define SLOAD(i, t) do { const bf16* kp_ = TK(t); const bf16* vp_ = TV(t); \
    sr_[i].vs0 = *reinterpret_cast<const bf16x8*>(vp_ + (long)sr * LDKV + sc); sr_[i].vs1 = *reinterpret_cast<const bf16x8*>(vp_ + (long)(32 + sr) * LDKV + sc); \
    sr_[i].ks0 = *reinterpret_cast<const bf16x8*>(kp_ + (long)sr * LDKV + sc); sr_[i].ks1 = *reinterpret_cast<const bf16x8*>(kp_ + (long)(32 + sr) * LDKV + sc); } while (0)
#define SWRITE(b, i) do { *(LAS bf16x8*)(V_lds + (b) * SHM_V + vst0) = sr_[i].vs0;          \
    *(LAS bf16x8*)(V_lds + (b) * SHM_V + vst1) = sr_[i].vs1; int kc = sc * 2;               \
    *(LAS bf16x8*)(K_lds + (b) * SHM_K + KSWZ(sr, kc)) = sr_[i].ks0;                       \
    *(LAS bf16x8*)(K_lds + (b) * SHM_K + KSWZ(32 + sr, kc)) = sr_[i].ks1; } while (0)
#define SWAIT() asm volatile("s_waitcnt vmcnt(4)" ::: "memory")
#define RESC(a) do { if (__any((a) < 1.f)) { if (hi == 0) al_l[r32] = (a); asm volatile("s_waitcnt lgkmcnt(0)" ::: "memory"); \
    _Pragma("unroll") for (int d = 0; d < 4; ++d) _Pragma("unroll") for (int r = 0; r < 16; ++r) o[d][r] *= al_l[crow(r, hi)]; } } while (0)
#define MASK(P0, P1, t) do { if (masked && (t) < nwt) wmask(P0, P1, (t) * KVBLK - qd, hi); } while (0)
  f32x16 pA0, pA1, pB0, pB1; float mnA, mnB, alA, alB; bf16x8 pa0, pa1, pa2, pa3;
  constexpr int SE = 0, SO = 1;
  SLOAD(SE, 0); asm volatile("s_waitcnt vmcnt(0)" ::: "memory"); SWRITE(0, SE); __syncthreads();
  qkt(pA0, pA1, K_lds, qr, r32, hi); MASK(pA0, pA1, 0); partialSM(pA0, pA1, m_reg, mnA, alA);
  SLOAD(SO, 1); if (2 < NT) SLOAD(SE, 2);
  SWAIT(); SWRITE(1, SO); __syncthreads();
  for (int j = 1; j + 1 < NT; j += 2) {
    SBAR(); qkt(pB0, pB1, K_lds + SHM_K, qr, r32, hi); MASK(pB0, pB1, j);
    finishSM(pA0, pA1, alA, l_reg, pa0, pa1, pa2, pa3); SBAR();
    SLOAD(SO, j + 2); SBAR();
    pv_d0(o, vb0, pa0, pa1, pa2, pa3); partialSM(pB0, pB1, m_reg, mnB, alB);
    __syncthreads(); SWAIT(); SWRITE(0, SE);
    RESC(alB); __syncthreads();
    SBAR(); qkt(pA0, pA1, K_lds, qr, r32, hi); MASK(pA0, pA1, j + 1);
    finishSM(pB0, pB1, alB, l_reg, pa0, pa1, pa2, pa3); SBAR();
    if (j + 3 < NT) SLOAD(SE, j + 3); SBAR();
    pv_d0(o, vb0 + SHM_V, pa0, pa1, pa2, pa3); partialSM(pA0, pA1, m_reg, mnA, alA);
    __syncthreads(); SWAIT(); SWRITE(1, SO);
    RESC(alA); __syncthreads();
  }
  SBAR(); qkt(pB0, pB1, K_lds + SHM_K, qr, r32, hi); MASK(pB0, pB1, NT - 1);
  finishSM(pA0, pA1, alA, l_reg, pa0, pa1, pa2, pa3); SBAR();
  pv_d0(o, vb0, pa0, pa1, pa2, pa3); partialSM(pB0, pB1, m_reg, mnB, alB);
  __syncthreads(); RESC(alB);
  finishSM(pB0, pB1, alB, l_reg, pa0, pa1, pa2, pa3); SBAR();
  pv_d0(o, vb0 + SHM_V, pa0, pa1, pa2, pa3);
  if (hi == 0) li_l[r32] = l_reg; asm volatile("s_waitcnt lgkmcnt(0)" ::: "memory");
  float rli[16];
#pragma unroll
  for (int r = 0; r < 16; ++r) rli[r] = __builtin_amdgcn_rcpf(li_l[crow(r, hi)]);
#pragma unroll
  for (int r = 0; r < 16; ++r) { const int orow = crow(r, hi);
#pragma unroll
    for (int d0 = 0; d0 < 4; ++d0) Ow[(long)orow * 1536 + d0 * 32 + r32] = (bf16)f2bf(o[d0][r] * rli[r]); }
  __syncthreads();
#undef TK
#undef TV
#undef SLOAD
#undef SWRITE
#undef SWAIT
#undef RESC
#undef MASK
}
#undef KSWZ
#undef SBAR
}

__device__ __forceinline__ void p3_attention(Frame& F) {
    const int wid = F.wave;
    const bf16* Qb = (const bf16*)(F.ws + WS_Q); const bf16* Kb = (const bf16*)(F.ws + WS_K); const bf16* Vb = (const bf16*)(F.ws + WS_V);
    const bf16* CK = (const bf16*)(F.ws + WS_CK); const bf16* CV = (const bf16*)(F.ws + WS_CV); bf16* AH = (bf16*)(F.ws + WS_AH);
    LAS char* lds = (LAS char*)(F.lds + RING_OFF);
    for (int it = F.vcu; it < 256 + 128; it += F.G) {
        const int lane = lane_id();
        int head, tok0, nwt, NT, qrel; bool masked; size_t krow, crow_; int kv;
        if (it < 256) {
            const int hp = it & 1, qb = (it >> 1) & 15, b = it >> 6; kv = (it >> 5) & 1;
            head = kv * 4 + hp * 2 + (wid >> 2);
            tok0 = M_CTX + b * L_LAT + qb * 128 + (wid & 3) * 32;
            const int kstart = qb == 0 ? 0 : (qb - 1) * 128, kend = qb == 15 ? L_LAT : (qb + 2) * 128; nwt = (kend - kstart) / 64; NT = nwt + 4;
            krow = (size_t)M_CTX + (size_t)b * L_LAT + kstart; crow_ = (size_t)b * 256; masked = true; qrel = qb * 128 + (wid & 3) * 32 - kstart;
        } else {
            const int ci = it - 256, b = ci >> 3; head = ci & 7; kv = head >> 2;
            tok0 = b * L_CTX + wid * 32; krow = (size_t)b * L_CTX; crow_ = 0; nwt = 4; NT = 4; masked = false; qrel = 0;
        }
        const float sinkl = inp(I_SINK)[head] * 1.4426950408889634f;
        att::attn_item(Qb + (size_t)tok0 * DM + head * HD, Kb + krow * KVW + kv * HD, Vb + krow * KVW + kv * HD,
                       CK + crow_ * KVW + kv * HD, CV + crow_ * KVW + kv * HD, nwt, NT, masked, qrel, sinkl, AH + (size_t)tok0 * KMIX + head * HD, lds, wid, lane);
    }
}


namespace hy {
typedef float f32x2 __attribute__((ext_vector_type(2)));
__device__ __forceinline__ f32x2 cmul(f32x2 a, f32x2 b) { return (f32x2){a.x * b.x - a.y * b.y, a.x * b.y + a.y * b.x}; }
template <bool INV> __device__ __forceinline__ f32x2 muli(f32x2 a) { return INV ? (f32x2){-a.y, a.x} : (f32x2){a.y, -a.x}; }
template <bool INV> __device__ __forceinline__ void dft8(f32x2 (&a)[8]) {
    const float r2 = 0.70710678118654752f;
    const f32x2 s0 = a[0] + a[4], d0 = a[0] - a[4], s1 = a[1] + a[5], d1 = a[1] - a[5], s2 = a[2] + a[6], d2 = a[2] - a[6], s3 = a[3] + a[7], d3 = a[3] - a[7];
    const f32x2 t0 = s0 + s2, t1 = s0 - s2, t2 = s1 + s3, t3 = muli<INV>(s1 - s3);
    a[0] = t0 + t2; a[4] = t0 - t2; a[2] = t1 + t3; a[6] = t1 - t3;
    const f32x2 e1 = INV ? (f32x2){(d1.x - d1.y) * r2, (d1.x + d1.y) * r2} : (f32x2){(d1.x + d1.y) * r2, (d1.y - d1.x) * r2};
    const f32x2 e3 = INV ? (f32x2){(-d3.x - d3.y) * r2, (d3.x - d3.y) * r2} : (f32x2){(d3.y - d3.x) * r2, (-d3.x - d3.y) * r2};
    const f32x2 e2 = muli<INV>(d2);
    const f32x2 u0 = d0 + e2, u1 = d0 - e2, u2 = e1 + e3, u3 = muli<INV>(e1 - e3);
    a[1] = u0 + u2; a[5] = u0 - u2; a[3] = u1 + u3; a[7] = u1 - u3;
}
template <bool INV> __device__ __forceinline__ void twiddle(f32x2 (&a)[8], float u) {
    const float c = __builtin_amdgcn_cosf(u), s = __builtin_amdgcn_sinf(u);
    const f32x2 w1 = (f32x2){c, INV ? s : -s};
    const f32x2 w2 = cmul(w1, w1), w3 = cmul(w2, w1), w4 = cmul(w2, w2), w5 = cmul(w4, w1), w6 = cmul(w3, w3), w7 = cmul(w4, w3);
    a[1] = cmul(a[1], w1); a[2] = cmul(a[2], w2); a[3] = cmul(a[3], w3); a[4] = cmul(a[4], w4); a[5] = cmul(a[5], w5); a[6] = cmul(a[6], w6); a[7] = cmul(a[7], w7);
}
__device__ __forceinline__ int layC(int e) { return e + ((e >> 6) << 3); }
__device__ __forceinline__ int layB(int e) { return e + (e >> 3); }
struct SyncWG { __device__ __forceinline__ void operator()() const { __syncthreads(); } };
struct SyncWave { __device__ __forceinline__ void operator()() const { asm volatile("s_waitcnt lgkmcnt(0)" ::: "memory"); } };
template <int NP, int MODE, class Sync>
__device__ __forceinline__ void fft_core(f32x2 (&a)[8], int i, LAS f32x2* C, LAS f32x2* B, f32x4* Hg, Sync sync) {
    constexpr int N = 1 << (3 * NP), Q0 = N / 8;
    dft8<false>(a); twiddle<false>(a, (float)i * (1.0f / N));
#pragma unroll
    for (int r = 0; r < 8; ++r) C[layC(i + Q0 * r)] = a[r];
    sync();
    if constexpr (NP == 4) {
        const int j = i & 63, e0 = (i >> 6) * 512 + j;
#pragma unroll
        for (int m = 0; m < 8; ++m) a[m] = C[layC(e0 + 64 * m)];
        dft8<false>(a); twiddle<false>(a, (float)j * (1.0f / 512));
#pragma unroll
        for (int r = 0; r < 8; ++r) C[layC(e0 + 64 * r)] = a[r];
        sync();
    }
    {
        const int j = i & 7, e0 = (i >> 3) * 64 + j;
#pragma unroll
        for (int m = 0; m < 8; ++m) a[m] = C[layC(e0 + 8 * m)];
        dft8<false>(a); twiddle<false>(a, (float)j * (1.0f / 64));
#pragma unroll
        for (int r = 0; r < 8; ++r) B[layB(e0 + 8 * r)] = a[r];
        sync();
    }
#pragma unroll
    for (int m = 0; m < 8; ++m) a[m] = B[9 * i + m];
    dft8<false>(a);
    if constexpr (MODE == 1) {
        const float sc = 1.0f / N;
#pragma unroll
        for (int mm = 0; mm < 4; ++mm) Hg[mm * Q0] = (f32x4){a[2 * mm].x * sc, a[2 * mm].y * sc, a[2 * mm + 1].x * sc, a[2 * mm + 1].y * sc};
    } else {
#pragma unroll
        for (int mm = 0; mm < 4; ++mm) { const f32x4 h = Hg[mm * Q0]; a[2 * mm] = cmul(a[2 * mm], (f32x2){h.x, h.y}); a[2 * mm + 1] = cmul(a[2 * mm + 1], (f32x2){h.z, h.w}); }
        dft8<true>(a);
#pragma unroll
        for (int m = 0; m < 8; ++m) B[9 * i + m] = a[m];
        sync();
        {
            const int j = i & 7, e0 = (i >> 3) * 64 + j;
#pragma unroll
            for (int r = 0; r < 8; ++r) a[r] = B[layB(e0 + 8 * r)];
            twiddle<true>(a, (float)j * (1.0f / 64)); dft8<true>(a);
#pragma unroll
            for (int m = 0; m < 8; ++m) C[layC(e0 + 8 * m)] = a[m];
            sync();
        }
        if constexpr (NP == 4) {
            const int j = i & 63, e0 = (i >> 6) * 512 + j;
#pragma unroll
            for (int r = 0; r < 8; ++r) a[r] = C[layC(e0 + 64 * r)];
            twiddle<true>(a, (float)j * (1.0f / 512)); dft8<true>(a);
#pragma unroll
            for (int m = 0; m < 8; ++m) C[layC(e0 + 64 * m)] = a[m];
            sync();
        }
#pragma unroll
        for (int r = 0; r < 8; ++r) a[r] = C[layC(i + Q0 * r)];
        twiddle<true>(a, (float)i * (1.0f / N)); dft8<true>(a);
    }
}
constexpr int BUF_SLOTS_L = 4096 + 512, BUF_SLOTS_C = 512 + 64;

__device__ __forceinline__ float hval(const bf16* HY, size_t base, int t, int L, int col) { return (t >= 0 && t < L) ? bf2f(HY[(base + t) * 1536 + col]) : 0.f; }
struct ConvW { float w0, w1, w2, b; };
__device__ __forceinline__ ConvW convw(int col) { const float* cw = inp(I_CONVW); ConvW w; w.w0 = cw[col]; w.w1 = cw[1536 + col]; w.w2 = cw[3072 + col]; w.b = inp(I_CONVB)[col]; return w; }
__device__ __forceinline__ float sconv(const bf16* HY, size_t base, int t, int L, int col, const ConvW& w) {
    return w.w0 * hval(HY, base, t - 1, L, col) + w.w1 * hval(HY, base, t, L, col) + w.w2 * hval(HY, base, t + 1, L, col) + w.b;
}
template <int NP, class Sync>
__device__ __forceinline__ void conv_item(const unsigned char* ws, int c, size_t base0, size_t base1, int i, LAS f32x2* C, LAS f32x2* B, f32x4* Hg, Sync sync) {
    constexpr int N = 1 << (3 * NP), L = N / 2, Q0 = N / 8;
    const bf16* HY = (const bf16*)(ws + WS_HY);
    const ConvW w1 = convw(512 + c), wv = convw(1024 + c);
    f32x2 a[8]; f32x2 z[4];
#pragma unroll
    for (int m = 0; m < 4; ++m) { const int t = i + Q0 * m;
        z[m].x = sconv(HY, base0, t, L, 512 + c, w1) * sconv(HY, base0, t, L, 1024 + c, wv);
        z[m].y = sconv(HY, base1, t, L, 512 + c, w1) * sconv(HY, base1, t, L, 1024 + c, wv);
        a[m] = z[m]; a[4 + m] = (f32x2){0.f, 0.f}; }
    fft_core<NP, 0, Sync>(a, i, C, B, Hg, sync);
    const ConvW w0 = convw(c); const float skip = inp(I_SKIP)[c];
    bf16* AH = (bf16*)(ws + WS_AH);
#pragma unroll
    for (int m = 0; m < 4; ++m) { const int t = i + Q0 * m;
        const float y0 = a[m].x + z[m].x * skip, y1 = a[m].y + z[m].y * skip;
        AH[(base0 + t) * KMIX + 1024 + c] = (bf16)f2bf(sconv(HY, base0, t, L, c, w0) * y0);
        AH[(base1 + t) * KMIX + 1024 + c] = (bf16)f2bf(sconv(HY, base1, t, L, c, w0) * y1); }
}
template <int NP, class Sync>
__device__ __forceinline__ void spec_item(const float* FSc, int i, LAS f32x2* C, LAS f32x2* B, f32x4* Hg, Sync sync) {
    constexpr int N = 1 << (3 * NP), Q0 = N / 8;
    f32x2 a[8];
#pragma unroll
    for (int m = 0; m < 8; ++m) a[m] = (f32x2){FSc[i + Q0 * m], 0.f};
    fft_core<NP, 1, Sync>(a, i, C, B, Hg, sync);
}
}

__device__ __forceinline__ void p1_spectra(Frame& F) {
    const int lane = lane_id(), wid = F.wave;
    LAS hy::f32x2* Cl = (LAS hy::f32x2*)(F.lds + RING_OFF); LAS hy::f32x2* Bl = Cl + hy::BUF_SLOTS_L;
    for (int c = F.vcu; c < HYW; c += F.G) {
        hy::spec_item<4>((const float*)(F.ws + WS_FSL) + (size_t)c * 4096, wid * 64 + lane, Cl, Bl, (f32x4*)(F.ws + WS_HL) + (size_t)c * 2048 + wid * 64 + lane, hy::SyncWG{});
        __syncthreads();
    }
    LAS hy::f32x2* Cw = (LAS hy::f32x2*)(F.lds + RING_OFF) + wid * 2 * hy::BUF_SLOTS_C; LAS hy::f32x2* Bw = Cw + hy::BUF_SLOTS_C;
    for (int g = F.vcu; g < HYW / 8; g += F.G) {
        const int c = g * 8 + wid;
        hy::spec_item<3>((const float*)(F.ws + WS_FSC) + (size_t)c * 512, lane, Cw, Bw, (f32x4*)(F.ws + WS_HC) + (size_t)c * 256 + lane, hy::SyncWave{});
    }
    __syncthreads();
}
__device__ __forceinline__ void p3_hyena(Frame& F) {
    const int wid = F.wave;
    LAS hy::f32x2* Cl = (LAS hy::f32x2*)(F.lds + RING_OFF); LAS hy::f32x2* Bl = Cl + hy::BUF_SLOTS_L;
    for (int it = F.vcu; it < HYW * 2; it += F.G) {
        const int lane = lane_id(), c = it >> 1, pair = it & 1;
        const size_t base0 = (size_t)M_CTX + (size_t)(2 * pair) * L_LAT;
        hy::conv_item<4>(F.ws, c, base0, base0 + L_LAT, wid * 64 + lane, Cl, Bl, (f32x4*)(F.ws + WS_HL) + (size_t)c * 2048 + wid * 64 + lane, hy::SyncWG{});
        __syncthreads();
    }
    LAS hy::f32x2* Cw = (LAS hy::f32x2*)(F.lds + RING_OFF) + wid * 2 * hy::BUF_SLOTS_C; LAS hy::f32x2* Bw = Cw + hy::BUF_SLOTS_C;
    for (int c = F.vcu; c < HYW; c += F.G) {
        const int lane = lane_id();
        const size_t base0 = (size_t)(2 * wid) * L_CTX;
        hy::conv_item<3>(F.ws, c, base0, base0 + L_CTX, lane, Cw, Bw, (f32x4*)(F.ws + WS_HC) + (size_t)c * 256 + lane, hy::SyncWave{});
    }
    __syncthreads();
}

__device__ __forceinline__ void p6_rows(Frame& F, const Args& A) {
    const int L_lane = lane_id();
    const int gw = F.vcu * NWAVES + F.wave, NGW = F.G * NWAVES;
    const float* MIX = (const float*)(F.ws + WS_F32); const float* MOD = (const float*)(F.ws + WS_MOD); bf16* XN = (bf16*)(F.ws + WS_XN);
    for (int m = gw; m < M; m += NGW) {
        const float* mod = MOD + (size_t)mod_row(m) * NMOD;
        const f32x4* xr = (const f32x4*)xrow_ptr(A, m) + L_lane; const f32x4* mr = (const f32x4*)(MIX + (size_t)m * DM) + L_lane;
        f32x4 v[4]; float s = 0.f;
#pragma unroll
        for (int j = 0; j < 4; ++j) { v[j] = mr[64 * j]; s += (v[j].x * v[j].x + v[j].y * v[j].y) + (v[j].z * v[j].z + v[j].w * v[j].w); }
        const float rstd = 1.0f / sqrtf(wave_sum(s) * (1.0f / DM) + EPS);
        float s2 = 0.f;
#pragma unroll
        for (int j = 0; j < 4; ++j) { const int c = 4 * L_lane + 256 * j;
            const f32x4 g1 = *(const f32x4*)(mod + 2 * DM + c), wp = *(const f32x4*)(inp(I_NMPOST) + c);
            v[j] = xr[64 * j] + g1 * (v[j] * rstd * wp);
            s2 += (v[j].x * v[j].x + v[j].y * v[j].y) + (v[j].z * v[j].z + v[j].w * v[j].w);
            *(f32x4*)(F.out + (size_t)m * DM + c) = v[j]; }
        const float rstd2 = 1.0f / sqrtf(wave_sum(s2) * (1.0f / DM) + EPS);
        unsigned long long* o8 = (unsigned long long*)(XN + (size_t)m * DM) + L_lane;
#pragma unroll
        for (int j = 0; j < 4; ++j) { const int c = 4 * L_lane + 256 * j;
            const f32x4 sh2 = *(const f32x4*)(mod + 3 * DM + c), sc2 = *(const f32x4*)(mod + 4 * DM + c), wp = *(const f32x4*)(inp(I_NFPRE) + c);
            const f32x4 hh = v[j] * rstd2 * wp * (1.0f + sc2) + sh2;
            o8[64 * j] = (unsigned long long)pk2(hh.x, hh.y) | ((unsigned long long)pk2(hh.z, hh.w) << 32); }
    }
}
__device__ __forceinline__ void p9_rows(Frame& F, const Args& A) {
    const int L_lane = lane_id();
    const int gw = F.vcu * NWAVES + F.wave, NGW = F.G * NWAVES;
    const float* FF = (const float*)(F.ws + WS_F32); const float* MOD = (const float*)(F.ws + WS_MOD);
    for (int m = gw; m < M; m += NGW) {
        const float* mod = MOD + (size_t)mod_row(m) * NMOD;
        const f32x4* fr = (const f32x4*)(FF + (size_t)m * DM) + L_lane;
        f32x4 v[4]; float s = 0.f;
#pragma unroll
        for (int j = 0; j < 4; ++j) { v[j] = fr[64 * j]; s += (v[j].x * v[j].x + v[j].y * v[j].y) + (v[j].z * v[j].z + v[j].w * v[j].w); }
        const float rstd = 1.0f / sqrtf(wave_sum(s) * (1.0f / DM) + EPS);
#pragma unroll
        for (int j = 0; j < 4; ++j) { const int c = 4 * L_lane + 256 * j;
            const f32x4 g2 = *(const f32x4*)(mod + 5 * DM + c), wp = *(const f32x4*)(inp(I_NFPOST) + c);
            float* o = F.out + (size_t)m * DM + c; *(f32x4*)o = *(const f32x4*)o + g2 * (v[j] * rstd * wp); }
    }
}

__global__ void __launch_bounds__(NTHR, 2) fwd_kernel(const Args args) {
    extern __shared__ __attribute__((aligned(16))) unsigned char lds[];
    Frame F;
    F.lds = (LAS unsigned char*)lds;
    F.MISC = (volatile LAS unsigned*)(F.lds + MISC_OFF);
    F.wave = __builtin_amdgcn_readfirstlane(threadIdx.x >> 6);
    F.G = gridDim.x; { const int bx = blockIdx.x; F.vcu = (F.G % 8 == 0) ? (bx % 8) * (F.G / 8) + bx / 8 : bx; }
    F.out = args.out; F.ws = args.ws;
    F.ctl = (gu32*)(F.ws + WS_CTL);
    for (int u = F.wave * 64 + lane_id(); u < (LDS_BYTES - LDSCTL_OFF) / 4; u += NTHR) ((LAS unsigned*)(F.lds + LDSCTL_OFF))[u] = 0u;
    __syncthreads();
    XcdBarrier bar; bar.bar = (unsigned*)(F.ctl + CW_BAR); bar.x = 0; bar.st = nullptr;
    if (N_LAUNCHES == 1) bar = xcd_barrier_post((unsigned*)(F.ctl + CW_BAR), F.MISC + 8, F.wave);
#define GRID_BAR() do { if (N_LAUNCHES == 1) xcd_barrier(bar, F.wave); } while (0)
    const int lo = args.ph_lo, hi = args.ph_hi;
#define IN(k) (lo <= (k) && (k) < hi)
#define BOTH(k) (IN(k) && IN((k) + 1))
    bf16* const XN = (bf16*)(F.ws + WS_XN);
    if (IN(0)) { p0_prologue(F, args); if (BOTH(0)) GRID_BAR(); }
    if (IN(1)) { p1_spectra(F); p1_rows(F, args); if (BOTH(1)) GRID_BAR(); }
    if (IN(2)) {
        pg8::Gemm g{XN, (const bf16*)(F.ws + WS_W1), M, NIN, DM}; pg8::StaticOrder S; S.init(M, NIN, F.G, (int)blockIdx.x);
        pg8::EpiIn E{(bf16*)(F.ws + WS_Q), (bf16*)(F.ws + WS_K), (bf16*)(F.ws + WS_V), (bf16*)(F.ws + WS_HY), (bf16*)(F.ws + WS_GT),
                     F.out + OUT_NEWK, F.out + OUT_NEWV, inp(I_BGATE), (const float*)(F.ws + WS_ROPE)};
        pg8::gemm_phase<pg8::EpiIn, pg8::StaticOrder, true, true>(F.lds + RING_OFF, g, S, E, F.wave);
        if (BOTH(2)) GRID_BAR();
    }
    if (IN(3)) { p3_attention(F); __syncthreads(); p3_hyena(F); if (BOTH(3)) GRID_BAR(); }
    if (IN(4)) {
        pg8::Gemm g{(const bf16*)(F.ws + WS_AH), (const bf16*)(F.ws + WS_W2), M, DM, KMIX}; pg8::StaticOrder S; S.init(M, DM, F.G, (int)blockIdx.x);
        pg8::EpiMerge E{(const bf16*)(F.ws + WS_GT), (bf16*)(F.ws + WS_MG)};
        pg8::gemm_phase<pg8::EpiMerge, pg8::StaticOrder, false, true>(F.lds + RING_OFF, g, S, E, F.wave);
        if (BOTH(4)) GRID_BAR();
    }
    if (IN(5)) {
        pg8::Gemm g{(const bf16*)(F.ws + WS_MG), (const bf16*)(F.ws + WS_W3), M, DM, DM}; pg8::StaticOrder S; S.init(M, DM, F.G, (int)blockIdx.x);
        pg8::EpiF32 E{(float*)(F.ws + WS_F32), DM};
        pg8::gemm_phase<pg8::EpiF32, pg8::StaticOrder, false, true>(F.lds + RING_OFF, g, S, E, F.wave);
        if (BOTH(5)) GRID_BAR();
    }
    if (IN(6)) { p6_rows(F, args); if (BOTH(6)) GRID_BAR(); }
    if (IN(7)) {
        pg8::Gemm g{XN, (const bf16*)(F.ws + WS_W4), M, NUP, DM}; pg8::StaticOrder S; S.init(M, NUP, F.G, (int)blockIdx.x);
        pg8::EpiSwiGLU E{(bf16*)(F.ws + WS_ACT), DFF};
        pg8::gemm_phase<pg8::EpiSwiGLU, pg8::StaticOrder, true, true>(F.lds + RING_OFF, g, S, E, F.wave);
        if (BOTH(7)) GRID_BAR();
    }
    if (IN(8)) {
        pg8::Gemm g{(const bf16*)(F.ws + WS_ACT), (const bf16*)(F.ws + WS_W5), M, DM, DFF}; pg8::StaticOrder S; S.init(M, DM, F.G, (int)blockIdx.x);
        pg8::EpiF32 E{(float*)(F.ws + WS_F32), DM};
        pg8::gemm_phase<pg8::EpiF32, pg8::StaticOrder, false, true>(F.lds + RING_OFF, g, S, E, F.wave);
        if (BOTH(8)) GRID_BAR();
    }
    if (IN(9)) { p9_rows(F, args); }
#undef IN
#undef BOTH
}

extern "C" void kernel_launch(void* const* d_in, const int* in_sizes, int n_in, void* d_out, int out_size, void* d_ws, size_t ws_size, hipStream_t stream) {
    static int grid = 0;
    if (grid == 0) {
        if (n_in != 33 || out_size != M * DM + 2 * M_CTX * KVW || ws_size < WS_END) { fprintf(stderr, "kernel_launch: unexpected sizes n_in %d out %d ws %zu\n", n_in, out_size, ws_size); grid = -1; return; }
        int dev = 0, cus = 0, per_cu = 0;
        if (hipGetDevice(&dev) != hipSuccess || hipDeviceGetAttribute(&cus, hipDeviceAttributeMultiprocessorCount, dev) != hipSuccess) { grid = -1; return; }
        if (hipFuncSetAttribute((const void*)fwd_kernel, hipFuncAttributeMaxDynamicSharedMemorySize, LDS_BYTES) != hipSuccess) { fprintf(stderr, "kernel_launch: hipFuncSetAttribute failed\n"); grid = -1; return; }
        if (hipOccupancyMaxActiveBlocksPerMultiprocessor(&per_cu, (const void*)fwd_kernel, NTHR, LDS_BYTES) != hipSuccess || per_cu < 1) { fprintf(stderr, "kernel_launch: occupancy query says %d\n", per_cu); }
        (void)hipGetLastError();
        grid = cus;
        if (grid != 256) fprintf(stderr, "kernel_launch: %d CUs (expected 256)\n", grid);
    }
    if (grid < 0) return;
    (void)hipMemsetAsync((char*)d_ws + WS_CTL, 0, CTL_ZERO_BYTES, stream);
    Args a{};
    for (int i = 0; i < 33; ++i) a.in[i] = (const float*)d_in[i];
    a.out = (float*)d_out; a.ws = (unsigned char*)d_ws;
    for (int li = 0; li < N_LAUNCHES; ++li) {
        a.ph_lo = (N_LAUNCHES == 1) ? 0 : li; a.ph_hi = (N_LAUNCHES == 1) ? N_PHASES : li + 1; a.li = li;
        hipLaunchKernelGGL(fwd_kernel, dim3(grid), dim3(NTHR), LDS_BYTES, stream, a);
    }
}
```

```cpp
#include <hip/hip_runtime.h>
#include <cstdio>
#include <cstdint>
__device__ __forceinline__ int lane_id() { int l; asm volatile("v_mbcnt_lo_u32_b32 %0, -1, 0\n\tv_mbcnt_hi_u32_b32 %0, -1, %0" : "=v"(l)); return l; }
namespace pg8 {
#define PG8_LAS __attribute__((address_space(3)))
typedef unsigned short bf16_t;
typedef short bf16x8 __attribute__((ext_vector_type(8)));
typedef float f32x4 __attribute__((ext_vector_type(4)));
typedef unsigned u32x4 __attribute__((ext_vector_type(4)));
constexpr int BM = 256, BK = 64, HALF = 128, HTB = HALF * BK * 2  , STAGE_BYTES = 8 * HTB, NXCD = 8, WGM = 8;

__host__ __device__ __forceinline__ int lds_byte(int r, int c) { const int st = (r >> 4) * 2 + (c >> 5), rr = r & 15, cc = c & 31, ob = rr * 64 + cc * 2; return st * 1024 + (ob ^ (((ob >> 9) & 1) << 5)); }
__host__ __device__ __forceinline__ void stage_rc(int b, int& R, int& C) { const int st = b / 1024, sb = b % 1024, swz = sb ^ (((sb >> 9) & 1) << 5); R = (st >> 1) * 16 + swz / 64; C = (st & 1) * 32 + (swz % 64) / 2; }
__host__ __device__ __forceinline__ int perm32(int rho) { const int n = rho >> 4, i = rho & 15; return 8 * (i >> 2) + 4 * n + (i & 3); }

struct Unit { int pm, pn, kind; };
struct Gemm { const bf16_t* A; const bf16_t* Bt; int M, N, K; const bf16_t* A2; const bf16_t* Bt2; };

struct StaticOrder {
    int nM, nN, nwg, G, c;
    __host__ __device__ void init(int M, int N, int G_, int c_) { nM = M / BM; nN = N / BM; nwg = nM * nN; G = G_; c = c_; }
    __host__ __device__ bool next(int i, Unit& u) const { const long L = (long)i * G + c; if (L >= nwg) return false; map((int)L, u); return true; }
    __host__ __device__ bool map(int L, Unit& u) const {
        u.kind = 0;
        int wgid = L; { const int q = nwg / NXCD, r = nwg % NXCD, xcd = wgid % NXCD, off = wgid / NXCD; wgid = (xcd < r ? xcd * (q + 1) : r * (q + 1) + (xcd - r) * q) + off; }
        const int nig = WGM * nN, gid = wgid / nig, fm = gid * WGM, gsz = (nM - fm) < WGM ? (nM - fm) : WGM;
        u.pm = fm + ((wgid % nig) % gsz); u.pn = (wgid % nig) / gsz; return true;
    }
    __device__ __forceinline__ void a_ready(const Unit&) const {}
    __device__ __forceinline__ void done(const Unit&) const {}
};


struct DualOrder {
    StaticOrder s0, s1; int G, c;
    __host__ __device__ void init(int M0, int N0, int M1, int N1, int G_, int c_) { s0.init(M0, N0, G_, c_); s1.init(M1, N1, G_, c_); G = G_; c = c_; }
    __host__ __device__ bool next(int i, Unit& u) const {
        const long L = (long)i * G + c;
        if (L < s1.nwg) { s1.map((int)L, u); u.kind = 1; return true; }
        if (L - s1.nwg < s0.nwg) { s0.map((int)(L - s1.nwg), u); return true; }
        return false; }
    __device__ __forceinline__ void a_ready(const Unit&) const {}
    __device__ __forceinline__ void done(const Unit&) const {}
};

__device__ __forceinline__ unsigned cvt_pk_bf16(float lo, float hi) { unsigned r; asm volatile("v_cvt_pk_bf16_f32 %0, %1, %2" : "=v"(r) : "v"(lo), "v"(hi)); return r; }
typedef float f32x2 __attribute__((ext_vector_type(2)));
typedef unsigned u32x2 __attribute__((ext_vector_type(2)));
__device__ __forceinline__ float bf_lo(unsigned w) { return __uint_as_float(w << 16); }
__device__ __forceinline__ float bf_hi(unsigned w) { return __uint_as_float(w & 0xffff0000u); }
__device__ __forceinline__ float sigmoid_f(float x) { return __builtin_amdgcn_rcpf(1.0f + __builtin_amdgcn_exp2f(-1.4426950408889634f * x)); }

constexpr int M_CTX = 4096;
constexpr float QSCALE = 0.088388347648318440f * 1.4426950408889634f;

struct EpiF32 {
    static constexpr bool PERM = false, AFTER_DRAIN = false; static constexpr int MID_T = -1;
    float* C; int ldc;
    __device__ __forceinline__ void mid(f32x4 (&acc)[2][2][4][2], const Unit& u, int wr, int wc, int fr, int fq) const {}
    __device__ __forceinline__ void operator()(const f32x4 (&acc)[2][2][4][2], const Unit& u, int wr, int wc, int fr, int fq) const {
        const int row0 = u.pm * BM + wr * 64 + fr, col0 = u.pn * BM + wc * 32 + 4 * fq;
#pragma unroll
        for (int ai = 0; ai < 2; ++ai)
#pragma unroll
            for (int m = 0; m < 4; ++m) { float* rowp = C + (size_t)(row0 + ai * HALF + m * 16) * ldc + col0;
#pragma unroll
                for (int bj = 0; bj < 2; ++bj)
#pragma unroll
                    for (int n = 0; n < 2; ++n) *(f32x4*)(rowp + bj * HALF + n * 16) = acc[ai][bj][m][n]; }
    }
};

struct EpiIn {
    static constexpr bool PERM = true, AFTER_DRAIN = false; static constexpr int MID_T = -1;
    bf16_t *Q, *Kb, *Vb, *HY, *GT; float *newk, *newv; const float* bgate; const float* rope;
    __device__ __forceinline__ void mid(f32x4 (&acc)[2][2][4][2], const Unit& u, int wr, int wc, int fr, int fq) const {}
    __device__ __forceinline__ void operator()(const f32x4 (&acc)[2][2][4][2], const Unit& u, int wr, int wc, int fr, int fq) const {
        const int pn = u.pn, rowb = u.pm * BM + wr * 64 + fr;
        if (u.kind == 1) {
            const int tok0 = pn * BM + wc * 32 + 8 * fq;
#pragma unroll
            for (int ai = 0; ai < 2; ++ai)
#pragma unroll
                for (int m = 0; m < 4; ++m) {
                    bf16_t* hp = HY + (size_t)(rowb + ai * HALF + m * 16) * 12288 + tok0;
#pragma unroll
                    for (int bj = 0; bj < 2; ++bj) { const f32x4 v0 = acc[ai][bj][m][0], v1 = acc[ai][bj][m][1];
                        u32x4 w; w.x = cvt_pk_bf16(v0[0], v0[1]); w.y = cvt_pk_bf16(v0[2], v0[3]); w.z = cvt_pk_bf16(v1[0], v1[1]); w.w = cvt_pk_bf16(v1[2], v1[3]);
                        *(u32x4*)(hp + bj * HALF) = w; }
                }
            return;
        }
        const bool latent = u.pm >= (M_CTX / BM);
        if (pn < 5) {
            const int fidx = ((wc & 1) * 4 + fq) * 4, d0 = (wc >> 1) * 64 + fidx;
            const bool isq = pn < 4; const float sc = isq ? QSCALE : 1.0f;
#pragma unroll
            for (int ai = 0; ai < 2; ++ai)
#pragma unroll
                for (int m = 0; m < 4; ++m) {
                    const int row = rowb + ai * HALF + m * 16;
                    f32x4 cs0 = (f32x4){1.f, 0.f, 1.f, 0.f}, cs1 = cs0;
                    if (latent) { const int t = (row - M_CTX) & 2047, pos = (wc >> 1) ? (t & 63) : (t >> 6);
                        const f32x4* rp = (const f32x4*)(rope + (size_t)(pos * 32 + fidx) * 2); cs0 = rp[0]; cs1 = rp[1]; }
#pragma unroll
                    for (int bj = 0; bj < 2; ++bj) {
                        const f32x4 x1 = acc[ai][bj][m][0], x2 = acc[ai][bj][m][1];
                        f32x4 o1, o2;
                        o1[0] = (x1[0] * cs0[0] - x2[0] * cs0[1]) * sc; o2[0] = (x1[0] * cs0[1] + x2[0] * cs0[0]) * sc;
                        o1[1] = (x1[1] * cs0[2] - x2[1] * cs0[3]) * sc; o2[1] = (x1[1] * cs0[3] + x2[1] * cs0[2]) * sc;
                        o1[2] = (x1[2] * cs1[0] - x2[2] * cs1[1]) * sc; o2[2] = (x1[2] * cs1[1] + x2[2] * cs1[0]) * sc;
                        o1[3] = (x1[3] * cs1[2] - x2[3] * cs1[3]) * sc; o2[3] = (x1[3] * cs1[3] + x2[3] * cs1[2]) * sc;
                        u32x2 w1, w2; w1.x = cvt_pk_bf16(o1[0], o1[1]); w1.y = cvt_pk_bf16(o1[2], o1[3]); w2.x = cvt_pk_bf16(o2[0], o2[1]); w2.y = cvt_pk_bf16(o2[2], o2[3]);
                        if (isq) { bf16_t* p = Q + (size_t)row * 1024 + (pn * 2 + bj) * 128 + d0; *(u32x2*)p = w1; *(u32x2*)(p + 32) = w2; }
                        else { bf16_t* p = Kb + (size_t)row * 256 + bj * 128 + d0; *(u32x2*)p = w1; *(u32x2*)(p + 32) = w2;
                            if (!latent) { float* q = newk + (size_t)row * 256 + bj * 128 + d0; *(f32x4*)q = o1; *(f32x4*)(q + 32) = o2; } }
                    }
                }
        } else {
            const int cin = wc * 32 + 8 * fq;
            bf16_t* base; int ld, col0;
            if (pn == 5) { base = Vb; ld = 256; col0 = 0; } else { base = GT; ld = 2048; col0 = (pn - 6) * BM; }
            f32x4 bv[2][2];
#pragma unroll
            for (int bj = 0; bj < 2; ++bj)
#pragma unroll
                for (int n = 0; n < 2; ++n) bv[bj][n] = (pn >= 6) ? *(const f32x4*)(bgate + col0 + bj * HALF + cin + 4 * n) : (f32x4){0.f, 0.f, 0.f, 0.f};
#pragma unroll
            for (int ai = 0; ai < 2; ++ai)
#pragma unroll
                for (int m = 0; m < 4; ++m) {
                    const int row = rowb + ai * HALF + m * 16;
#pragma unroll
                    for (int bj = 0; bj < 2; ++bj) {
                        f32x4 v0 = acc[ai][bj][m][0] + bv[bj][0], v1 = acc[ai][bj][m][1] + bv[bj][1];
                        if (pn >= 6) {
#pragma unroll
                            for (int j = 0; j < 4; ++j) { v0[j] = sigmoid_f(v0[j]); v1[j] = sigmoid_f(v1[j]); } }
                        u32x4 w; w.x = cvt_pk_bf16(v0[0], v0[1]); w.y = cvt_pk_bf16(v0[2], v0[3]); w.z = cvt_pk_bf16(v1[0], v1[1]); w.w = cvt_pk_bf16(v1[2], v1[3]);
                        *(u32x4*)(base + (size_t)row * ld + col0 + bj * HALF + cin) = w;
                        if (pn == 5 && !latent) { float* q = newv + (size_t)row * 256 + bj * HALF + cin; *(f32x4*)q = v0; *(f32x4*)(q + 4) = v1; }
                    }
                }
        }
    }
};

struct EpiMerge {
    static constexpr bool PERM = true, AFTER_DRAIN = false; static constexpr int MID_T = 16;
    const bf16_t* GT; bf16_t* MG;
    __device__ __forceinline__ void mid(f32x4 (&acc)[2][2][4][2], const Unit& u, int wr, int wc, int fr, int fq) const {
        const int rowb = u.pm * BM + wr * 64 + fr, colb = u.pn * BM + wc * 32 + 8 * fq;
#pragma unroll
        for (int ai = 0; ai < 2; ++ai)
#pragma unroll
            for (int m = 0; m < 4; ++m) {
                const bf16_t* g = GT + (size_t)(rowb + ai * HALF + m * 16) * 2048 + colb;
#pragma unroll
                for (int bj = 0; bj < 2; ++bj) {
                    const u32x4 ga = *(const u32x4*)(g + bj * HALF), gh = *(const u32x4*)(g + 1024 + bj * HALF);
                    f32x4& a0 = acc[ai][bj][m][0]; f32x4& a1 = acc[ai][bj][m][1];
                    a0[0] *= bf_lo(ga.x) * __builtin_amdgcn_rcpf(bf_lo(gh.x)); a0[1] *= bf_hi(ga.x) * __builtin_amdgcn_rcpf(bf_hi(gh.x));
                    a0[2] *= bf_lo(ga.y) * __builtin_amdgcn_rcpf(bf_lo(gh.y)); a0[3] *= bf_hi(ga.y) * __builtin_amdgcn_rcpf(bf_hi(gh.y));
                    a1[0] *= bf_lo(ga.z) * __builtin_amdgcn_rcpf(bf_lo(gh.z)); a1[1] *= bf_hi(ga.z) * __builtin_amdgcn_rcpf(bf_hi(gh.z));
                    a1[2] *= bf_lo(ga.w) * __builtin_amdgcn_rcpf(bf_lo(gh.w)); a1[3] *= bf_hi(ga.w) * __builtin_amdgcn_rcpf(bf_hi(gh.w));
                }
            }
    }
    __device__ __forceinline__ void operator()(const f32x4 (&acc)[2][2][4][2], const Unit& u, int wr, int wc, int fr, int fq) const {
        const int rowb = u.pm * BM + wr * 64 + fr, colb = u.pn * BM + wc * 32 + 8 * fq;
#pragma unroll
        for (int ai = 0; ai < 2; ++ai)
#pragma unroll
            for (int m = 0; m < 4; ++m) {
                const size_t ro = (size_t)(rowb + ai * HALF + m * 16);
#pragma unroll
                for (int bj = 0; bj < 2; ++bj) {
                    const u32x4 gh = *(const u32x4*)(GT + ro * 2048 + 1024 + colb + bj * HALF);
                    const f32x4 a0 = acc[ai][bj][m][0], a1 = acc[ai][bj][m][1];
                    u32x4 w; w.x = cvt_pk_bf16(a0[0] * bf_lo(gh.x), a0[1] * bf_hi(gh.x)); w.y = cvt_pk_bf16(a0[2] * bf_lo(gh.y), a0[3] * bf_hi(gh.y));
                    w.z = cvt_pk_bf16(a1[0] * bf_lo(gh.z), a1[1] * bf_hi(gh.z)); w.w = cvt_pk_bf16(a1[2] * bf_lo(gh.w), a1[3] * bf_hi(gh.w));
                    *(u32x4*)(MG + ro * 1024 + colb + bj * HALF) = w;
                }
            }
    }
};

struct EpiSwiGLU {
    static constexpr bool PERM = true, AFTER_DRAIN = false; static constexpr int MID_T = -1;
    bf16_t* ACT; int ld;
    __device__ __forceinline__ void mid(f32x4 (&acc)[2][2][4][2], const Unit& u, int wr, int wc, int fr, int fq) const {}
    __device__ __forceinline__ void operator()(const f32x4 (&acc)[2][2][4][2], const Unit& u, int wr, int wc, int fr, int fq) const {
        const int rowb = u.pm * BM + wr * 64 + fr, colb = u.pn * HALF + wc * 32 + 8 * fq;
#pragma unroll
        for (int ai = 0; ai < 2; ++ai)
#pragma unroll
            for (int m = 0; m < 4; ++m) {
                float o[8];
#pragma unroll
                for (int n = 0; n < 2; ++n)
#pragma unroll
                    for (int j = 0; j < 4; ++j) { const float g = acc[ai][0][m][n][j], up = acc[ai][1][m][n][j]; o[n * 4 + j] = g * sigmoid_f(g) * up; }
                u32x4 w; w.x = cvt_pk_bf16(o[0], o[1]); w.y = cvt_pk_bf16(o[2], o[3]); w.z = cvt_pk_bf16(o[4], o[5]); w.w = cvt_pk_bf16(o[6], o[7]);
                *(u32x4*)(ACT + (size_t)(rowb + ai * HALF + m * 16) * ld + colb) = w;
            }
    }
};

template <class Epi, class Sched, bool ALIGN_EPI = false, bool SP2 = false>
__device__ __forceinline__ void gemm_phase(PG8_LAS unsigned char* lds, const Gemm g, const Sched& S, const Epi& E, const int wid) {
    const int lane = lane_id(), tid = wid * 64 + lane, wr = wid >> 2, wc = wid & 3, fr = lane & 15, fq = lane >> 4;
    const int K = g.K, nt = K / BK;
    unsigned voffA[2], voffB[2];
#pragma unroll
    for (int i = 0; i < 2; ++i) { int R, C; stage_rc(tid * 16 + i * 8192, R, C); const int Rb = Epi::PERM ? ((R & ~31) + perm32(R & 31)) : R;
        voffA[i] = (unsigned)(R * K + C) * 2u; voffB[i] = (unsigned)(Rb * K + C) * 2u; }
    const size_t kstep = (size_t)(BK * 2);
    const size_t hstep = (size_t)HALF * K * 2;
    const size_t tstep = 2 * hstep;
    const unsigned ldsw = (unsigned)wid * 1024u;
    const int aoff = lds_byte(wr * 64 + fr, fq * 8), boff = lds_byte(wc * 32 + fr, fq * 8);
#define PG8_SA(b, h) (((b) * 2 + (h)) * HTB)
#define PG8_SB(b, h) ((4 + (b) * 2 + (h)) * HTB)
#define PG8_STAGE(bufoff, gbase, voff) do { _Pragma("unroll") for (int _i = 0; _i < 2; ++_i) \
        __builtin_amdgcn_global_load_lds((const unsigned*)((const char*)(gbase) + (voff)[_i]), (PG8_LAS unsigned*)(lds + (bufoff) + ldsw + _i * 8192), 16, 0, 0); } while (0)
#define PG8_LDA(dst, b, h) do { _Pragma("unroll") for (int m = 0; m < 4; ++m) _Pragma("unroll") for (int k = 0; k < 2; ++k) dst[m][k] = *(const PG8_LAS bf16x8*)(lds + PG8_SA(b, h) + aoff + m * 2048 + k * 1024); } while (0)
#define PG8_LDB(dst, b, h) do { _Pragma("unroll") for (int n = 0; n < 2; ++n) _Pragma("unroll") for (int k = 0; k < 2; ++k) dst[n][k] = *(const PG8_LAS bf16x8*)(lds + PG8_SB(b, h) + boff + n * 2048 + k * 1024); } while (0)
#define PG8_MMA(ai, bj, At, Bt) do { __builtin_amdgcn_s_setprio(1); _Pragma("unroll") for (int m = 0; m < 4; ++m) _Pragma("unroll") for (int n = 0; n < 2; ++n) _Pragma("unroll") for (int k = 0; k < 2; ++k) \
        acc[ai][bj][m][n] = __builtin_amdgcn_mfma_f32_16x16x32_bf16(Bt[n][k], At[m][k], acc[ai][bj][m][n], 0, 0, 0); __builtin_amdgcn_s_setprio(0); } while (0)
#define PG8_WAIT_V(n) asm volatile("s_waitcnt vmcnt(" #n ")" ::: "memory")
#define PG8_WAIT_L(n) asm volatile("s_waitcnt lgkmcnt(" #n ")" ::: "memory")
#define PG8_BAR __builtin_amdgcn_s_barrier()
#define PG8_SCHED __builtin_amdgcn_sched_barrier(0)
    Unit cur, nxt; int ui = 0;
    if (!S.next(0, cur)) return;
    f32x4 acc[2][2][4][2];
#pragma unroll
    for (int a = 0; a < 2; ++a)
#pragma unroll
        for (int b = 0; b < 2; ++b)
#pragma unroll
            for (int m = 0; m < 4; ++m)
#pragma unroll
                for (int n = 0; n < 2; ++n) acc[a][b][m][n] = (f32x4){0.f, 0.f, 0.f, 0.f};
    bf16x8 At[4][2], B0[2][2], B1[2][2];
    const char* cA = (const char*)(cur.kind ? g.A2 : g.A) + (size_t)cur.pm * tstep; const char* cB = (const char*)(cur.kind ? g.Bt2 : g.Bt) + (size_t)cur.pn * tstep;
    S.a_ready(cur);
    if constexpr (SP2) {
        PG8_STAGE(PG8_SB(0, 0), cB, voffB); PG8_STAGE(PG8_SB(0, 1), cB + hstep, voffB); PG8_STAGE(PG8_SA(0, 0), cA, voffA); PG8_STAGE(PG8_SA(0, 1), cA + hstep, voffA);
        if (wr == 1) PG8_BAR;
        PG8_WAIT_V(2); PG8_BAR;
        PG8_STAGE(PG8_SB(1, 0), cB + kstep, voffB); PG8_STAGE(PG8_SA(1, 0), cA + kstep, voffA); PG8_STAGE(PG8_SB(1, 1), cB + hstep + kstep, voffB);
        PG8_WAIT_V(6); PG8_BAR;
    } else {
        PG8_STAGE(PG8_SB(0, 0), cB, voffB); PG8_STAGE(PG8_SA(0, 0), cA, voffA); PG8_STAGE(PG8_SB(0, 1), cB + hstep, voffB); PG8_STAGE(PG8_SA(0, 1), cA + hstep, voffA);
        if (wr == 1) PG8_BAR;
        PG8_WAIT_V(4); PG8_BAR;
        PG8_STAGE(PG8_SB(1, 0), cB + kstep, voffB); PG8_STAGE(PG8_SA(1, 0), cA + kstep, voffA); PG8_STAGE(PG8_SB(1, 1), cB + hstep + kstep, voffB);
        PG8_WAIT_V(6); PG8_BAR;
    }
    for (;;) {
        const bool has_next = S.next(ui + 1, nxt);
        const char* nA = has_next ? (const char*)(nxt.kind ? g.A2 : g.A) + (size_t)nxt.pm * tstep : cA; const char* nB = has_next ? (const char*)(nxt.kind ? g.Bt2 : g.Bt) + (size_t)nxt.pn * tstep : cB;
        for (int t = 0; t < nt; t += 2) {
            if constexpr (Epi::MID_T >= 0) { if (t == Epi::MID_T) E.mid(acc, cur, wr, wc, fr, fq); }
            const bool last = (t == nt - 2);
            const char* a1 = cA + (size_t)(t + 1) * kstep;
            const char* a2 = last ? nA : cA + (size_t)(t + 2) * kstep; const char* b2 = last ? nB : cB + (size_t)(t + 2) * kstep;
            const char* a3 = a2 + kstep; const char* b3 = b2 + kstep;
            if (last && has_next) S.a_ready(nxt);
            if constexpr (SP2) {
            PG8_LDB(B0, 0, 0); PG8_LDB(B1, 0, 1); PG8_SCHED; PG8_LDA(At, 0, 0); PG8_STAGE(PG8_SA(1, 1), a1 + hstep, voffA);
            PG8_WAIT_V(8); PG8_WAIT_L(0); PG8_BAR; PG8_MMA(0, 0, At, B0); PG8_MMA(0, 1, At, B1); PG8_BAR; PG8_SCHED;
            PG8_LDA(At, 0, 1); PG8_STAGE(PG8_SB(0, 0), b2, voffB); PG8_STAGE(PG8_SB(0, 1), b2 + hstep, voffB); PG8_STAGE(PG8_SA(0, 0), a2, voffA);
            PG8_WAIT_V(8); PG8_WAIT_L(0); PG8_BAR; PG8_MMA(1, 0, At, B0); PG8_MMA(1, 1, At, B1); PG8_BAR; PG8_SCHED;
            PG8_LDB(B0, 1, 0); PG8_LDB(B1, 1, 1); PG8_SCHED; PG8_LDA(At, 1, 0); PG8_STAGE(PG8_SA(0, 1), a2 + hstep, voffA);
            PG8_WAIT_V(8); PG8_WAIT_L(0); PG8_BAR; PG8_MMA(0, 0, At, B0); PG8_MMA(0, 1, At, B1); PG8_BAR; PG8_SCHED;
            PG8_LDA(At, 1, 1); PG8_STAGE(PG8_SB(1, 0), b3, voffB); PG8_STAGE(PG8_SB(1, 1), b3 + hstep, voffB); PG8_STAGE(PG8_SA(1, 0), a3, voffA);
            PG8_WAIT_V(8); PG8_WAIT_L(0); PG8_BAR; PG8_MMA(1, 0, At, B0); PG8_MMA(1, 1, At, B1); PG8_BAR; PG8_SCHED;
            } else {
            PG8_LDB(B0, 0, 0); PG8_SCHED; PG8_LDA(At, 0, 0); PG8_STAGE(PG8_SA(1, 1), a1 + hstep, voffA);
            PG8_WAIT_L(8); PG8_BAR; PG8_WAIT_L(0); PG8_MMA(0, 0, At, B0); PG8_BAR; PG8_SCHED;
            PG8_LDB(B1, 0, 1); PG8_STAGE(PG8_SB(0, 0), b2, voffB);
            PG8_BAR; PG8_WAIT_L(0); PG8_MMA(0, 1, At, B1); PG8_BAR;
            PG8_LDA(At, 0, 1); PG8_STAGE(PG8_SA(0, 0), a2, voffA);
            PG8_BAR; PG8_WAIT_L(0); PG8_MMA(1, 0, At, B0); PG8_BAR; PG8_SCHED;
            PG8_STAGE(PG8_SB(0, 1), b2 + hstep, voffB);
            PG8_WAIT_V(6); PG8_BAR; PG8_MMA(1, 1, At, B1); PG8_BAR;
            PG8_LDB(B0, 1, 0); PG8_SCHED; PG8_LDA(At, 1, 0); PG8_STAGE(PG8_SA(0, 1), a2 + hstep, voffA);
            PG8_WAIT_L(8); PG8_BAR; PG8_WAIT_L(0); PG8_MMA(0, 0, At, B0); PG8_BAR; PG8_SCHED;
            PG8_LDB(B1, 1, 1); PG8_STAGE(PG8_SB(1, 0), b3, voffB);
            PG8_BAR; PG8_WAIT_L(0); PG8_MMA(0, 1, At, B1); PG8_BAR;
            PG8_LDA(At, 1, 1); PG8_STAGE(PG8_SA(1, 0), a3, voffA);
            PG8_BAR; PG8_WAIT_L(0); PG8_MMA(1, 0, At, B0); PG8_BAR; PG8_SCHED;
            PG8_STAGE(PG8_SB(1, 1), b3 + hstep, voffB);
            PG8_WAIT_V(6); PG8_BAR; PG8_MMA(1, 1, At, B1); PG8_BAR;
            }
        }
        if constexpr (ALIGN_EPI) { if (wr == 0) PG8_BAR; }
        if constexpr (!Epi::AFTER_DRAIN) { E(acc, cur, wr, wc, fr, fq); S.done(cur); }
        if (!has_next) break;
#pragma unroll
        for (int a = 0; a < 2; ++a)
#pragma unroll
            for (int b = 0; b < 2; ++b)
#pragma unroll
                for (int m = 0; m < 4; ++m)
#pragma unroll
                    for (int n = 0; n < 2; ++n) acc[a][b][m][n] = (f32x4){0.f, 0.f, 0.f, 0.f};
        cur = nxt; cA = nA; cB = nB; ++ui;
        if constexpr (ALIGN_EPI) { if (wr == 1) PG8_BAR; }
    }
    PG8_WAIT_V(0);
    if constexpr (!ALIGN_EPI) { if (wr == 0) PG8_BAR; }
    PG8_BAR;
    if constexpr (Epi::AFTER_DRAIN) { E.fused(acc, cur, wr, wc, fr, fq, lds, wid, lane); S.done(cur); }
#undef PG8_SA
#undef PG8_SB
#undef PG8_STAGE
#undef PG8_LDA
#undef PG8_LDB
#undef PG8_MMA
#undef PG8_WAIT_V
#undef PG8_WAIT_L
#undef PG8_BAR
#undef PG8_SCHED
}
}


constexpr int NWAVES = 8, NTHR = NWAVES * 64;
#ifndef MK_N_LAUNCHES
#define MK_N_LAUNCHES 1
#endif
constexpr int N_PHASES = 10;
#ifndef PROBE_PHASE
#define PROBE_PHASE -1
#endif
constexpr int N_LAUNCHES = MK_N_LAUNCHES;
constexpr int DM = 1024, M_CTX = pg8::M_CTX, L_CTX = 256, B_CTX = 16, M_LAT = 8192, L_LAT = 2048, B_LAT = 4, M = M_CTX + M_LAT;
constexpr int NHEAD = 8, NKV = 2, HD = 128, KVW = 256, HYW = 512, NIN = 3072 + 2048, KMIX = 1024 + 512, DFF = 2816, NUP = 2 * DFF;
constexpr int NMOD = 6 * DM, MOD_KS = 16;
constexpr float EPS = 1e-6f;
constexpr int OUT_Y = 0, OUT_NEWK = M * DM, OUT_NEWV = OUT_NEWK + M_CTX * KVW;

constexpr size_t MiB = 1u << 20;
constexpr size_t WS_CTL = 0, CTL_ZERO_BYTES = 1 * MiB;
constexpr size_t WS_W1 = 2 * MiB;
constexpr size_t WS_W2 = 12 * MiB;
constexpr size_t WS_W3 = 15 * MiB;
constexpr size_t WS_W4 = 17 * MiB;
constexpr size_t WS_W5 = 28 * MiB;
constexpr size_t WS_MODP = 34 * MiB;
constexpr size_t WS_MOD = 36 * MiB;
constexpr size_t WS_ROPE = 36 * MiB + 256 * 1024;
constexpr size_t WS_CK = 37 * MiB;
constexpr size_t WS_CV = 37 * MiB + 512 * 1024;
constexpr size_t WS_FSL = 38 * MiB;
constexpr size_t WS_FSC = 46 * MiB;
constexpr size_t WS_HL = 228 * MiB;
constexpr size_t WS_HC = 244 * MiB;
constexpr size_t WS_XN = 48 * MiB;
constexpr size_t WS_Q = 72 * MiB;
constexpr size_t WS_K = 96 * MiB;
constexpr size_t WS_V = 102 * MiB;
constexpr size_t WS_HY = 108 * MiB;
constexpr size_t WS_GT = 144 * MiB;
constexpr size_t WS_AH = 192 * MiB;
constexpr size_t WS_MG = 72 * MiB;
constexpr size_t WS_ACT = 72 * MiB;
constexpr size_t WS_F32 = 144 * MiB;
constexpr size_t WS_END = 252 * MiB;
static_assert(WS_ACT + (size_t)M * DFF * 2 <= WS_GT && WS_F32 + (size_t)M * DM * 4 <= WS_AH && WS_MG + (size_t)M * DM * 2 <= WS_K && WS_HC + 2 * MiB <= WS_END && WS_FSC + MiB <= WS_XN, "d_ws map");
constexpr int CW_TMO = 0, CW_CODE = 1, CW_BAR = 4096;

constexpr int RING_OFF = 0, RING_BYTES = 131072;
constexpr int LDSCTL_OFF = RING_BYTES, MISC_OFF = LDSCTL_OFF + 320;
constexpr int LDS_BYTES = 147456;
static_assert(MISC_OFF + 128 <= LDS_BYTES, "LDS map");

#define GAS __attribute__((address_space(1)))
#define LAS __attribute__((address_space(3)))
typedef unsigned short bf16;
typedef unsigned v4u __attribute__((ext_vector_type(4)));
typedef unsigned v2u __attribute__((ext_vector_type(2)));
typedef float f32x4 __attribute__((ext_vector_type(4)));
typedef GAS unsigned gu32;
#define RLX_AGENT __ATOMIC_RELAXED, __HIP_MEMORY_SCOPE_AGENT
#define LDS_WAIT() asm volatile("s_waitcnt lgkmcnt(0)" ::: "memory")
#define VM_WAIT() asm volatile("s_waitcnt vmcnt(0)" ::: "memory")
__device__ __forceinline__ unsigned f2bf(float f) { unsigned u = __builtin_bit_cast(unsigned, f); return (u + 0x7fffu + ((u >> 16) & 1u)) >> 16; }
__device__ __forceinline__ unsigned pk2(float lo, float hi) { return f2bf(lo) | (f2bf(hi) << 16); }
__device__ __forceinline__ float bf2f(bf16 v) { return __uint_as_float((unsigned)v << 16); }
__device__ __forceinline__ float wave_sum(float v) {
#pragma unroll
    for (int o = 1; o < 64; o <<= 1) v += __shfl_xor(v, o);
    return v;
}
__device__ __forceinline__ float wave_max(float v) {
#pragma unroll
    for (int o = 1; o < 64; o <<= 1) v = fmaxf(v, __shfl_xor(v, o));
    return v;
}

#define XB_TMO      128
#define XB_XCNT(j)  (256  + 64 * (j))
#define XB_XSUB(j)  (1280 + 64 * (j))
#define XB_XGEN(j)  (2304 + 64 * (j))
#define XB_TOP      3328
#define XB_TOPGEN   3392
#define XCD_BAR_WORDS 3456
#define XB_SPIN_CAP (1u << 18)

__device__ __forceinline__ unsigned xb_ld(unsigned* p)              { return __hip_atomic_load(p, __ATOMIC_RELAXED, __HIP_MEMORY_SCOPE_AGENT); }
__device__ __forceinline__ unsigned xb_add(unsigned* p, unsigned v) { return __hip_atomic_fetch_add(p, v, __ATOMIC_RELAXED, __HIP_MEMORY_SCOPE_AGENT); }
__device__ __forceinline__ unsigned xb_xcc_id() { return (unsigned)__builtin_amdgcn_s_getreg((3 << 11) | 20) & 0xFu; }
#define XB_SPIN(cond, bar) do { unsigned _sp = 0; while (cond) { __builtin_amdgcn_s_sleep(1); \
    if ((++_sp & 255u) == 0u) { if (xb_ld(&(bar)[XB_TMO])) break; if (_sp > XB_SPIN_CAP) { atomicAdd(&(bar)[XB_TMO], 1u); break; } } } } while (0)

struct XcdBarrier {
    unsigned* bar; unsigned x;
    volatile LAS unsigned* st;
};

__device__ __forceinline__ XcdBarrier xcd_barrier_post(unsigned* bar, volatile LAS unsigned* st, int wave) {
    XcdBarrier b; b.bar = bar; b.x = xb_xcc_id(); b.st = st;
    if (wave == 0 && lane_id() == 0) (void)xb_add(&bar[XB_XCNT(b.x)], 1u);
    return b;
}
__device__ __forceinline__ void xcd_barrier_complete(unsigned* bar, unsigned x, unsigned& nloc, unsigned& nx) {
    const unsigned G = gridDim.x * gridDim.y * gridDim.z;
    unsigned sum, cnt, mine, sp = 0u;
    for (;;) {
        sum = 0u; cnt = 0u; mine = 0u;
#pragma unroll
        for (unsigned j = 0; j < 16; ++j) { const unsigned c = xb_ld(&bar[XB_XCNT(j)]); sum += c; cnt += (c > 0u) ? 1u : 0u; mine = (j == x) ? c : mine; }
        if (sum == G) break;
        __builtin_amdgcn_s_sleep(1);
        if ((++sp & 255u) == 0u) { if (xb_ld(&bar[XB_TMO])) break; if (sp > XB_SPIN_CAP) { atomicAdd(&bar[XB_TMO], 1u); break; } }
    }
    nloc = mine > 0u ? mine : 1u; nx = cnt > 0u ? cnt : 1u;
}

__device__ __forceinline__ void xcd_barrier(const XcdBarrier& b, int wave) {
    asm volatile("s_waitcnt vmcnt(0)" ::: "memory");
    __syncthreads();
    if (wave == 0 && lane_id() == 0) {
        unsigned* bar = b.bar;
        __builtin_amdgcn_s_waitcnt(0);
        unsigned nloc = b.st[0], nx = b.st[1];
        if (nloc == 0u) { xcd_barrier_complete(bar, b.x, nloc, nx); b.st[0] = nloc; b.st[1] = nx; }
        const unsigned old = xb_add(&bar[XB_XSUB(b.x)], 1u);
        const unsigned gen = old / nloc;
        if (old + 1u == (gen + 1u) * nloc) {
            __builtin_amdgcn_fence(__ATOMIC_RELEASE, "agent");
            asm volatile("s_waitcnt vmcnt(0)" ::: "memory");
            const unsigned og = xb_add(&bar[XB_TOP], 1u);
            const unsigned tg = og / nx;
            if (og + 1u == (tg + 1u) * nx) xb_add(&bar[XB_TOPGEN], 1u);
            else XB_SPIN(xb_ld(&bar[XB_TOPGEN]) == tg, bar);
            __builtin_amdgcn_fence(__ATOMIC_ACQUIRE, "agent");
            xb_add(&bar[XB_XGEN(b.x)], 1u);
            asm volatile("s_waitcnt vmcnt(0)" ::: "memory");
        } else {
            XB_SPIN(xb_ld(&bar[XB_XGEN(b.x)]) == gen, bar);
            __builtin_amdgcn_fence(__ATOMIC_ACQUIRE, "agent");
            asm volatile("s_waitcnt vmcnt(0)" ::: "memory");
        }
    }
    __syncthreads();
}

struct Args { const float* in[33]; float* out; unsigned char* ws; int ph_lo, ph_hi, li, pad; };
struct Frame {
    LAS unsigned char* lds;
    volatile LAS unsigned* MISC;
    gu32* ctl;
    int wave;
    int vcu, G;
    float* out; unsigned char* ws;
};
typedef const float* const __attribute__((address_space(4))) * kargp_t;
__device__ __forceinline__ const float* inp(int i) { return ((kargp_t)__builtin_amdgcn_kernarg_segment_ptr())[i]; }
enum { I_XP = 0, I_XS, I_C, I_CK, I_CV, I_CCTX, I_NMPRE, I_NMPOST, I_NFPRE, I_NFPOST, I_WMOD, I_BMOD, I_WIN, I_SINK, I_CONVW, I_CONVB,
       I_FW1, I_FB1, I_FFR1, I_FW2, I_FB2, I_FFR2, I_FW3, I_FB3, I_FDEC, I_SKIP, I_WPA, I_WPH, I_WGATE, I_BGATE, I_WO, I_WUP, I_WDOWN };

__device__ __forceinline__ const float* xrow_ptr(const Args& A, int m) { return m < M_CTX ? inp(I_XP) + (size_t)m * DM : inp(I_XS) + (size_t)(m - M_CTX) * DM; }
__device__ __forceinline__ int mod_row(int m) { return m < M_CTX ? 0 : 1 + ((m - M_CTX) >> 11); }

template <class Map>
__device__ __forceinline__ void p0_transpose_item(const float* W, int K, int N, bf16* WT, int ldk, int koff, Map map, LAS float* scr, int item, int lane) {
    const int nblk = N / 32, kb = item / nblk, nb = item % nblk, k0 = 64 * kb, n0 = 32 * nb;
#pragma unroll 8
    for (int i = 0; i < 32; ++i) { const int kk = 2 * i + (lane >> 5); scr[kk * 33 + (lane & 31)] = W[(size_t)(k0 + kk) * N + n0 + (lane & 31)]; }
    LDS_WAIT(); asm volatile("" ::: "memory");
    const int c = lane & 7;
#pragma unroll
    for (int j = 0; j < 4; ++j) { const int n = (lane >> 3) + 8 * j; const LAS float* s = scr + (8 * c) * 33 + n;
        v4u o; o.x = pk2(s[0 * 33], s[1 * 33]); o.y = pk2(s[2 * 33], s[3 * 33]); o.z = pk2(s[4 * 33], s[5 * 33]); o.w = pk2(s[6 * 33], s[7 * 33]);
        *(GAS v4u*)(WT + (size_t)map(n0 + n) * ldk + koff + k0 + 8 * c) = o; }
    LDS_WAIT(); asm volatile("" ::: "memory");
}
struct MapIn {
    __device__ __forceinline__ int operator()(int n) const {
        if (n >= 1536) return n + 2048;
        if (n >= 1280) return n;
        const int d = n & 127, half = d >> 6, r = d & 63, nn = r >> 5, q = r & 31, idx8 = q >> 2, j = q & 3, wc = half * 2 + (idx8 >> 2), fq = idx8 & 3;
        return (n & ~127) + 32 * wc + 8 * fq + 4 * nn + j; }
};
struct MapOff { int off; __device__ __forceinline__ int operator()(int n) const { return n + off; } };
struct MapUp {
    __device__ __forceinline__ int operator()(int n) const { const int up = n >= DFF ? 1 : 0, i = n - up * DFF; return (i >> 7) * 256 + up * 128 + (i & 127); }
};

__device__ __forceinline__ float silu_f(float x) { return x / (1.0f + __expf(-x)); }

__device__ __forceinline__ void p0_filter_item(int item, int L, float* FS, LAS float* scr, int lane) {
    const int tb = item >> 2, cb = item & 3, bwd = cb >> 1, tfirst = tb * 16 + bwd, col = cb * 256 + lane * 4;
    LAS float* feat = scr;
    LAS float* h1T = scr + 320;
    LAS float* h2T = scr + 320 + 1024;
    const float invL = 1.0f / (float)L;
    {
        const int k = lane >> 2, b0 = (lane & 3) * 2; const float tt = (float)(tfirst + k);
        const float base = (6.283185307179586f * tt) * invL;
#pragma unroll
        for (int q = 0; q < 2; ++q) { const float band = 1e-4f + (float)(b0 + q) * ((7.0f - 1e-4f) / 7.0f); const float ang = base * band;
            feat[k * 20 + 1 + b0 + q] = cosf(ang); feat[k * 20 + 9 + b0 + q] = sinf(ang); }
        if ((lane & 3) == 0) feat[k * 20] = tt * invL;
    }
    LDS_WAIT(); asm volatile("" ::: "memory");
    {
        float w1c[17];
#pragma unroll
        for (int f = 0; f < 17; ++f) w1c[f] = inp(I_FW1)[f * 64 + lane];
        const float b1 = inp(I_FB1)[lane], fr1 = inp(I_FFR1)[lane];
#pragma unroll 4
        for (int k = 0; k < 16; ++k) { float s = b1;
#pragma unroll
            for (int f = 0; f < 17; ++f) s += feat[k * 20 + f] * w1c[f];
            h1T[lane * 16 + k] = sinf(fr1 * s); }
    }
    LDS_WAIT(); asm volatile("" ::: "memory");
    {
        float s2[16]; const float b2 = inp(I_FB2)[lane], fr2 = inp(I_FFR2)[lane];
#pragma unroll
        for (int k = 0; k < 16; ++k) s2[k] = b2;
#pragma unroll 4
        for (int j = 0; j < 64; ++j) { const float w = inp(I_FW2)[j * 64 + lane];
#pragma unroll
            for (int g = 0; g < 4; ++g) { const f32x4 h = *(const LAS f32x4*)(h1T + j * 16 + 4 * g); s2[4 * g] += h.x * w; s2[4 * g + 1] += h.y * w; s2[4 * g + 2] += h.z * w; s2[4 * g + 3] += h.w * w; } }
#pragma unroll
        for (int k = 0; k < 16; ++k) h2T[lane * 16 + k] = sinf(fr2 * s2[k]);
    }
    LDS_WAIT(); asm volatile("" ::: "memory");
    f32x4 acc[16];
    { const f32x4 b3 = *(const f32x4*)(inp(I_FB3) + col);
#pragma unroll
      for (int k = 0; k < 16; ++k) acc[k] = b3; }
#pragma unroll 4
    for (int j = 0; j < 64; ++j) { const f32x4 w = *(const f32x4*)(inp(I_FW3) + (size_t)j * 1024 + col);
#pragma unroll
        for (int g = 0; g < 4; ++g) { const f32x4 h = *(const LAS f32x4*)(h2T + j * 16 + 4 * g);
            acc[4 * g] += h.x * w; acc[4 * g + 1] += h.y * w; acc[4 * g + 2] += h.z * w; acc[4 * g + 3] += h.w * w; } }
    const f32x4 dec = *(const f32x4*)(inp(I_FDEC) + col);
#pragma unroll
    for (int k = 0; k < 16; ++k) { const float tn = (float)(tfirst + k) * invL; const bool dead = (tfirst + k) >= L;
#pragma unroll
        for (int q = 0; q < 4; ++q) acc[k][q] = dead ? 0.f : acc[k][q] * __expf(-tn * fabsf(dec[q])); }
    const int N2 = 2 * L;
    if (!bwd) {
#pragma unroll
        for (int q = 0; q < 4; ++q) { float* p = FS + (size_t)(col + q) * N2 + tfirst;
#pragma unroll
            for (int g = 0; g < 4; ++g) *(f32x4*)(p + 4 * g) = (f32x4){acc[4 * g][q], acc[4 * g + 1][q], acc[4 * g + 2][q], acc[4 * g + 3][q]}; }
    } else {
#pragma unroll
        for (int q = 0; q < 4; ++q) { float* p = FS + (size_t)(col - 512 + q) * N2 + (N2 - tfirst - 15);
#pragma unroll
            for (int g = 0; g < 4; ++g) *(f32x4*)(p + 4 * g) = (f32x4){acc[15 - 4 * g][q], acc[14 - 4 * g][q], acc[13 - 4 * g][q], acc[12 - 4 * g][q]}; }
    }
    LDS_WAIT(); asm volatile("" ::: "memory");
}

__device__ __forceinline__ void p0_prologue(Frame& F, const Args& A) {
    const int L_lane = lane_id();
    LAS float* scr = (LAS float*)(F.lds + RING_OFF + F.wave * 16384);
    const int gw = F.vcu * NWAVES + F.wave, NGW = F.G * NWAVES, lane = L_lane;
    bf16* W1 = (bf16*)(F.ws + WS_W1); bf16* W2 = (bf16*)(F.ws + WS_W2); bf16* W3 = (bf16*)(F.ws + WS_W3); bf16* W4 = (bf16*)(F.ws + WS_W4); bf16* W5 = (bf16*)(F.ws + WS_W5);
    constexpr int N_FILT_L = (L_LAT / 16) * 4, N_FILT = N_FILT_L + (L_CTX / 16) * 4;
    constexpr int T_IN = (DM / 64) * (3072 / 32), T_GATE = (DM / 64) * (2048 / 32), T_PA = (DM / 64) * (DM / 32), T_PH = (HYW / 64) * (DM / 32), T_O = T_PA,
                  T_UP = (DM / 64) * (NUP / 32), T_DOWN = (DFF / 64) * (DM / 32);
    constexpr int N_MODI = (NMOD / 256) * MOD_KS, N_ROPE = 32, N_CACHE = 2 * (B_LAT * 256 * KVW) / 512;
    constexpr int NITEMS = N_FILT + T_IN + T_GATE + T_PA + T_PH + T_O + T_UP + T_DOWN + N_MODI + N_ROPE + N_CACHE;
    for (int it = gw; it < NITEMS; it += NGW) {
        int r = it;
        if (r < N_FILT) { if (r < N_FILT_L) p0_filter_item(r, L_LAT, (float*)(F.ws + WS_FSL), scr, lane); else p0_filter_item(r - N_FILT_L, L_CTX, (float*)(F.ws + WS_FSC), scr, lane); continue; } r -= N_FILT;
        if (r < T_IN) { p0_transpose_item(inp(I_WIN), DM, 3072, W1, DM, 0, MapIn{}, scr, r, lane); continue; } r -= T_IN;
        if (r < T_GATE) { p0_transpose_item(inp(I_WGATE), DM, 2048, W1, DM, 0, MapOff{1536}, scr, r, lane); continue; } r -= T_GATE;
        if (r < T_PA) { p0_transpose_item(inp(I_WPA), DM, DM, W2, KMIX, 0, MapOff{0}, scr, r, lane); continue; } r -= T_PA;
        if (r < T_PH) { p0_transpose_item(inp(I_WPH), HYW, DM, W2, KMIX, DM, MapOff{0}, scr, r, lane); continue; } r -= T_PH;
        if (r < T_O) { p0_transpose_item(inp(I_WO), DM, DM, W3, DM, 0, MapOff{0}, scr, r, lane); continue; } r -= T_O;
        if (r < T_UP) { p0_transpose_item(inp(I_WUP), DM, NUP, W4, DM, 0, MapUp{}, scr, r, lane); continue; } r -= T_UP;
        if (r < T_DOWN) { p0_transpose_item(inp(I_WDOWN), DFF, DM, W5, DFF, 0, MapOff{0}, scr, r, lane); continue; } r -= T_DOWN;
        if (r < N_MODI) {
            const int cg = r / MOD_KS, ks = r % MOD_KS, col = cg * 256 + lane * 4;
            f32x4 acc[5];
#pragma unroll
            for (int q = 0; q < 5; ++q) acc[q] = (f32x4){0.f, 0.f, 0.f, 0.f};
            for (int k = ks * 64; k < ks * 64 + 64; ++k) {
                const f32x4 w = *(const f32x4*)(inp(I_WMOD) + (size_t)k * NMOD + col);
                acc[0] += silu_f(inp(I_CCTX)[k]) * w;
#pragma unroll
                for (int q = 1; q < 5; ++q) acc[q] += silu_f(inp(I_C)[(q - 1) * DM + k]) * w;
            }
            float* mp = (float*)(F.ws + WS_MODP) + (size_t)ks * 5 * NMOD + col;
#pragma unroll
            for (int q = 0; q < 5; ++q) *(f32x4*)(mp + q * NMOD) = acc[q];
            continue; } r -= N_MODI;
        if (r < N_ROPE) {
            const int pos = 2 * r + (lane >> 5), f = lane & 31;
            const float inv = expf(-(float)f * (9.210340371976184f / 32.0f));
            const float ang = (float)pos * inv;
            float* rp = (float*)(F.ws + WS_ROPE) + (size_t)(pos * 32 + f) * 2; rp[0] = cosf(ang); rp[1] = sinf(ang);
            continue; } r -= N_ROPE;
        {
            const int half = (B_LAT * 256 * KVW) / 512; const bool isv = r >= half; const int idx = (isv ? r - half : r) * 512 + lane * 8;
            const float* src = (isv ? inp(I_CV) : inp(I_CK)) + idx; bf16* dst = (bf16*)(F.ws + (isv ? WS_CV : WS_CK)) + idx;
            const f32x4 a = *(const f32x4*)src, b = *(const f32x4*)(src + 4);
            v4u o; o.x = pk2(a.x, a.y); o.y = pk2(a.z, a.w); o.z = pk2(b.x, b.y); o.w = pk2(b.z, b.w); *(v4u*)dst = o;
        }
    }
}

__device__ __forceinline__ float mod_total(const Frame& F, const Args& A, int r, int col) {
    const float* mp = (const float*)(F.ws + WS_MODP) + (size_t)r * NMOD + col; float s = inp(I_BMOD)[col];
#pragma unroll
    for (int ks = 0; ks < MOD_KS; ++ks) s += mp[(size_t)ks * 5 * NMOD];
    return s;
}
__device__ __forceinline__ void p1_rows(Frame& F, const Args& A) {
    const int L_lane = lane_id(), L_tid = F.wave * 64 + L_lane;
    if (F.vcu < 30) {
        const int r = F.vcu / 6, c0 = (F.vcu % 6) * 1024;
        for (int i = L_tid; i < 1024; i += NTHR) ((float*)(F.ws + WS_MOD))[r * NMOD + c0 + i] = mod_total(F, A, r, c0 + i);
    }
    LAS float* vA = (LAS float*)(F.lds + RING_OFF); LAS float* vB = vA + DM;
    int cur = -1;
    bf16* XN = (bf16*)(F.ws + WS_XN);
    for (int ch = 0; ch < 3; ++ch) {
        const int row0 = F.vcu * 48 + ch * 16;
        if (row0 >= M) break;
        const int r = mod_row(row0);
        if (r != cur) {
            __syncthreads();
            for (int i = L_tid; i < DM; i += NTHR) { vA[i] = inp(I_NMPRE)[i] * (1.0f + mod_total(F, A, r, DM + i)); vB[i] = mod_total(F, A, r, i); }
            __syncthreads(); cur = r;
        }
#pragma unroll 1
        for (int q = 0; q < 2; ++q) {
            const int m = row0 + F.wave * 2 + q;
            const f32x4* xr = (const f32x4*)xrow_ptr(A, m) + L_lane;
            f32x4 v[4]; float s = 0.f;
#pragma unroll
            for (int j = 0; j < 4; ++j) { v[j] = xr[64 * j]; s += (v[j].x * v[j].x + v[j].y * v[j].y) + (v[j].z * v[j].z + v[j].w * v[j].w); }
            const float rstd = 1.0f / sqrtf(wave_sum(s) * (1.0f / DM) + EPS);
            unsigned long long* o8 = (unsigned long long*)(XN + (size_t)m * DM) + L_lane;
#pragma unroll
            for (int j = 0; j < 4; ++j) { const int c = 4 * L_lane + 256 * j;
                const float a = v[j].x * rstd * vA[c] + vB[c], b = v[j].y * rstd * vA[c + 1] + vB[c + 1], cc = v[j].z * rstd * vA[c + 2] + vB[c + 2], d = v[j].w * rstd * vA[c + 3] + vB[c + 3];
                o8[64 * j] = (unsigned long long)pk2(a, b) | ((unsigned long long)pk2(cc, d) << 32); }
        }
    }
}


namespace att {
using bf16x8 = __attribute__((ext_vector_type(8))) short;
using s16x4  = __attribute__((ext_vector_type(4))) short;
using f32x16 = __attribute__((ext_vector_type(16))) float;
using u32x4  = __attribute__((ext_vector_type(4))) unsigned;
constexpr int D = 128, NW = 8, QBLK = 32, KVBLK = 64, LDKV = 256;
constexpr int SHM_V = KVBLK * D * 2, SHM_K = KVBLK * D * 2, SHM_ATTN = 2 * SHM_V + 2 * SHM_K + NW * 64 * 4;
constexpr float THR2 = 8.0f;
#define KSWZ(row, colB) ((row) * 256 + ((colB) ^ (((row) & 7) << 4)))
#define SBAR() __builtin_amdgcn_sched_barrier(0)
__device__ __forceinline__ int crow(int r, int hi) { return (r & 3) + 8 * (r >> 2) + 4 * hi; }
__device__ __forceinline__ unsigned cvtpk(float lo, float hi) { unsigned r; asm volatile("v_cvt_pk_bf16_f32 %0, %1, %2" : "=v"(r) : "v"(lo), "v"(hi)); return r; }
__device__ __forceinline__ void partialSM(f32x16& p0, f32x16& p1, float& m_reg, float& mn, float& alpha) {
  float pmax = p0[0];
#pragma unroll
  for (int r = 1; r < 16; ++r) pmax = fmaxf(pmax, p0[r]);
#pragma unroll
  for (int r = 0; r < 16; ++r) pmax = fmaxf(pmax, p1[r]);
  { auto rr = __builtin_amdgcn_permlane32_swap(__float_as_uint(pmax), __float_as_uint(pmax), false, false);
    pmax = fmaxf(__uint_as_float(rr[0]), __uint_as_float(rr[1])); }
  if (__builtin_expect(__all(pmax - m_reg <= THR2), 1)) { mn = m_reg; alpha = 1.f; }
  else { mn = fmaxf(m_reg, pmax); alpha = __builtin_amdgcn_exp2f(m_reg - mn); m_reg = mn; }
#pragma unroll
  for (int r = 0; r < 16; ++r) p0[r] = p0[r] - mn;
#pragma unroll
  for (int r = 0; r < 16; ++r) p1[r] = p1[r] - mn;
#pragma unroll
  for (int r = 0; r < 16; ++r) p0[r] = __builtin_amdgcn_exp2f(p0[r]);
}
__device__ __forceinline__ void finishSM(f32x16& p0, f32x16& p1, float alpha, float& l_reg, bf16x8& pa0, bf16x8& pa1, bf16x8& pa2, bf16x8& pa3) {
#pragma unroll
  for (int r = 0; r < 16; ++r) p1[r] = __builtin_amdgcn_exp2f(p1[r]);
  float ps = 0;
#pragma unroll
  for (int r = 0; r < 16; ++r) ps += p0[r];
#pragma unroll
  for (int r = 0; r < 16; ++r) ps += p1[r];
  { auto rr = __builtin_amdgcn_permlane32_swap(__float_as_uint(ps), __float_as_uint(ps), false, false);
    ps = __uint_as_float(rr[0]) + __uint_as_float(rr[1]); }
  l_reg = l_reg * alpha + ps;
#define PK4(P, BASE, OUT) do { unsigned a0 = cvtpk(P[BASE + 0], P[BASE + 1]), a1 = cvtpk(P[BASE + 2], P[BASE + 3]);   \
    unsigned b0 = cvtpk(P[BASE + 4], P[BASE + 5]), b1 = cvtpk(P[BASE + 6], P[BASE + 7]);                              \
    auto r0 = __builtin_amdgcn_permlane32_swap(a0, b0, false, false); auto r1 = __builtin_amdgcn_permlane32_swap(a1, b1, false, false); \
    u32x4 w = {r0[0], r1[0], r0[1], r1[1]}; OUT = *reinterpret_cast<bf16x8*>(&w); } while (0)
  PK4(p0, 0, pa0); PK4(p0, 8, pa1); PK4(p1, 0, pa2); PK4(p1, 8, pa3);
#undef PK4
}
__device__ __forceinline__ void qkt(f32x16& p0, f32x16& p1, const LAS char* Ks, const bf16x8* qr, int r32, int hi) {
  p0 = f32x16{}; p1 = f32x16{};
#pragma unroll
  for (int d0 = 0; d0 < 8; ++d0) { int cb = (d0 * 16 + hi * 8) * 2;
    bf16x8 b0 = *reinterpret_cast<const LAS bf16x8*>(Ks + KSWZ(r32, cb));
    bf16x8 b1 = *reinterpret_cast<const LAS bf16x8*>(Ks + KSWZ(32 + r32, cb));
    p0 = __builtin_amdgcn_mfma_f32_32x32x16_bf16(b0, qr[d0], p0, 0, 0, 0);
    p1 = __builtin_amdgcn_mfma_f32_32x32x16_bf16(b1, qr[d0], p1, 0, 0, 0); }
}
__device__ __forceinline__ void wmask(f32x16& p0, f32x16& p1, int kd, int hi) {
  const int b = kd + 4 * hi;
#pragma unroll
  for (int r = 0; r < 16; ++r) { const int d = b + (r & 3) + 8 * (r >> 2);
    if (d > 128 || d < -128) p0[r] = -1e30f;
    if (d + 32 > 128 || d + 32 < -128) p1[r] = -1e30f; }
}
__device__ __forceinline__ int v_st(int k, int c) { const int kk = (k & ~0xC) | ((k & 4) << 1) | ((k & 8) >> 1); return ((kk >> 3) * 4 + (c >> 5)) * 512 + ((kk & 7) * 32 + (c & 31)) * 2; }
__device__ __forceinline__ int v_rd_base(int lane) { return ((lane & 3) << 3) | (((lane >> 2) & 3) << 6) | (((lane >> 4) & 1) << 5) | (((lane >> 5) & 1) << 8); }
constexpr int v_rd_off(int d0, int ks, int half) { return d0 * 512 + ks * 4096 + half * 2048; }
template <int OFF> __device__ __forceinline__ s16x4 tr_read(int vb) {
  s16x4 r; asm volatile("ds_read_b64_tr_b16 %0, %1 offset:%2" : "=&v"(r) : "v"(vb), "i"(OFF) : "memory"); return r;
}
template <int D0> __device__ __forceinline__ void pv_one(f32x16& od, int vb, bf16x8 pa0, bf16x8 pa1, bf16x8 pa2, bf16x8 pa3) {
  const s16x4 l0 = tr_read<v_rd_off(D0, 0, 0)>(vb), h0 = tr_read<v_rd_off(D0, 0, 1)>(vb), l1 = tr_read<v_rd_off(D0, 1, 0)>(vb), h1 = tr_read<v_rd_off(D0, 1, 1)>(vb);
  const s16x4 l2 = tr_read<v_rd_off(D0, 2, 0)>(vb), h2 = tr_read<v_rd_off(D0, 2, 1)>(vb), l3 = tr_read<v_rd_off(D0, 3, 0)>(vb), h3 = tr_read<v_rd_off(D0, 3, 1)>(vb);
  asm volatile("s_waitcnt lgkmcnt(0)" ::: "memory"); SBAR();
#define PK(L, H) (bf16x8){L[0], L[1], L[2], L[3], H[0], H[1], H[2], H[3]}
  od = __builtin_amdgcn_mfma_f32_32x32x16_bf16(pa0, PK(l0, h0), od, 0, 0, 0);
  od = __builtin_amdgcn_mfma_f32_32x32x16_bf16(pa1, PK(l1, h1), od, 0, 0, 0);
  od = __builtin_amdgcn_mfma_f32_32x32x16_bf16(pa2, PK(l2, h2), od, 0, 0, 0);
  od = __builtin_amdgcn_mfma_f32_32x32x16_bf16(pa3, PK(l3, h3), od, 0, 0, 0);
#undef PK
}
__device__ __forceinline__ void pv_d0(f32x16* o, int vb, bf16x8 pa0, bf16x8 pa1, bf16x8 pa2, bf16x8 pa3) {
  pv_one<0>(o[0], vb, pa0, pa1, pa2, pa3); pv_one<1>(o[1], vb, pa0, pa1, pa2, pa3); pv_one<2>(o[2], vb, pa0, pa1, pa2, pa3); pv_one<3>(o[3], vb, pa0, pa1, pa2, pa3);
}
__device__ __forceinline__ void attn_item(const bf16* Qw, const bf16* Kw, const bf16* Vw, const bf16* Kc, const bf16* Vc, int nwt, int NT, bool masked, int qrel,
                                          float sinkl, bf16* Ow, LAS char* lds, int wid, int lane) {
  const int tid = wid * 64 + lane, r32 = lane & 31, hi = lane >> 5;
  LAS char* V_lds = lds; LAS char* K_lds = lds + 2 * SHM_V;
  LAS float* ws = (LAS float*)(lds + 2 * SHM_V + 2 * SHM_K) + wid * 64; LAS float* li_l = ws; LAS float* al_l = ws + 32;
  float m_reg = sinkl, l_reg = 1.0f; f32x16 o[4] = {}; bf16x8 qr[8];
  const bf16* Qp = Qw + (long)r32 * 1024 + hi * 8;
#pragma unroll
  for (int d0 = 0; d0 < 8; ++d0) qr[d0] = *reinterpret_cast<const bf16x8*>(Qp + d0 * 16);
  const int sr = tid >> 4, sc = (tid & 15) * 8, vst0 = v_st(sr, sc), vst1 = v_st(32 + sr, sc);
  const int vb0 = (int)(uintptr_t)V_lds + v_rd_base(lane);
  const int qd = qrel + r32;
  struct { bf16x8 vs0, vs1, ks0, ks1; } sr_[2];
#define TK(t) (((t) < nwt) ? Kw + (long)(t) * KVBLK * LDKV : Kc + (long)((t) - nwt) * KVBLK * LDKV)
#define TV(t) (((t) < nwt) ? Vw + (long)(t) * KVBLK * LDKV : Vc + (long)((t) - nwt) * KVBLK * LDKV)
#define SLOAD(i, t) do { const bf16* kp_ = TK(t); const bf16* vp_ = TV(t); \
    sr_[i].vs0 = *reinterpret_cast<const bf16x8*>(vp_ + (long)sr * LDKV + sc); sr_[i].vs1 = *reinterpret_cast<const bf16x8*>(vp_ + (long)(32 + sr) * LDKV + sc); \
    sr_[i].ks0 = *reinterpret_cast<const bf16x8*>(kp_ + (long)sr * LDKV + sc); sr_[i].ks1 = *reinterpret_cast<const bf16x8*>(kp_ + (long)(32 + sr) * LDKV + sc); } while (0)
#define SWRITE(b, i) do { *(LAS bf16x8*)(V_lds + (b) * SHM_V + vst0) = sr_[i].vs0;          \
    *(LAS bf16x8*)(V_lds + (b) * SHM_V + vst1) = sr_[i].vs1; int kc = sc * 2;               \
    *(LAS bf16x8*)(K_lds + (b) * SHM_K + KSWZ(sr, kc)) = sr_[i].ks0;                       \
    *(LAS bf16x8*)(K_lds + (b) * SHM_K + KSWZ(32 + sr, kc)) = sr_[i].ks1; } while (0)
#define SWAIT() asm volatile("s_waitcnt vmcnt(4)" ::: "memory")
#define RESC(a) do { if (__any((a) < 1.f)) { if (hi == 0) al_l[r32] = (a); asm volatile("s_waitcnt lgkmcnt(0)" ::: "memory"); \
    _Pragma("unroll") for (int d = 0; d < 4; ++d) _Pragma("unroll") for (int r = 0; r < 16; ++r) o[d][r] *= al_l[crow(r, hi)]; } } while (0)
#define MASK(P0, P1, t) do { if (masked && (t) < nwt) wmask(P0, P1, (t) * KVBLK - qd, hi); } while (0)
  f32x16 pA0, pA1, pB0, pB1; float mnA, mnB, alA, alB; bf16x8 pa0, pa1, pa2, pa3;
  constexpr int SE = 0, SO = 1;
  SLOAD(SE, 0); asm volatile("s_waitcnt vmcnt(0)" ::: "memory"); SWRITE(0, SE); __syncthreads();
  qkt(pA0, pA1, K_lds, qr, r32, hi); MASK(pA0, pA1, 0); partialSM(pA0, pA1, m_reg, mnA, alA);
  SLOAD(SO, 1); if (2 < NT) SLOAD(SE, 2);
  SWAIT(); SWRITE(1, SO); __syncthreads();
  for (int j = 1; j + 1 < NT; j += 2) {
    SBAR(); qkt(pB0, pB1, K_lds + SHM_K, qr, r32, hi); MASK(pB0, pB1, j);
    finishSM(pA0, pA1, alA, l_reg, pa0, pa1, pa2, pa3); SBAR();
    SLOAD(SO, j + 2); SBAR();
    pv_d0(o, vb0, pa0, pa1, pa2, pa3); partialSM(pB0, pB1, m_reg, mnB, alB);
    __syncthreads(); SWAIT(); SWRITE(0, SE);
    RESC(alB); __syncthreads();
    SBAR(); qkt(pA0, pA1, K_lds, qr, r32, hi); MASK(pA0, pA1, j + 1);
    finishSM(pB0, pB1, alB, l_reg, pa0, pa1, pa2, pa3); SBAR();
    if (j + 3 < NT) SLOAD(SE, j + 3); SBAR();
    pv_d0(o, vb0 + SHM_V, pa0, pa1, pa2, pa3); partialSM(pA0, pA1, m_reg, mnA, alA);
    __syncthreads(); SWAIT(); SWRITE(1, SO);
    RESC(alA); __syncthreads();
  }
  SBAR(); qkt(pB0, pB1, K_lds + SHM_K, qr, r32, hi); MASK(pB0, pB1, NT - 1);
  finishSM(pA0, pA1, alA, l_reg, pa0, pa1, pa2, pa3); SBAR();
  pv_d0(o, vb0, pa0, pa1, pa2, pa3); partialSM(pB0, pB1, m_reg, mnB, alB);
  __syncthreads(); RESC(alB);
  finishSM(pB0, pB1, alB, l_reg, pa0, pa1, pa2, pa3); SBAR();
  pv_d0(o, vb0 + SHM_V, pa0, pa1, pa2, pa3);
  if (hi == 0) li_l[r32] = l_reg; asm volatile("s_waitcnt lgkmcnt(0)" ::: "memory");
  float rli[16];
#pragma unroll
  for (int r = 0; r < 16; ++r) rli[r] = __builtin_amdgcn_rcpf(li_l[crow(r, hi)]);
#pragma unroll
  for (int r = 0; r < 16; ++r) { const int orow = crow(r, hi);
#pragma unroll
    for (int d0 = 0; d0 < 4; ++d0) Ow[(long)orow * 1536 + d0 * 32 + r32] = (bf16)f2bf(o[d0][r] * rli[r]); }
  __syncthreads();
#undef TK
#undef TV
#undef SLOAD
#undef SWRITE
#undef SWAIT
#undef RESC
#undef MASK
}
#undef KSWZ
#undef SBAR
}

__device__ __forceinline__ void p3_attention(Frame& F) {
    const int wid = F.wave;
    const bf16* Qb = (const bf16*)(F.ws + WS_Q); const bf16* Kb = (const bf16*)(F.ws + WS_K); const bf16* Vb = (const bf16*)(F.ws + WS_V);
    const bf16* CK = (const bf16*)(F.ws + WS_CK); const bf16* CV = (const bf16*)(F.ws + WS_CV); bf16* AH = (bf16*)(F.ws + WS_AH);
    LAS char* lds = (LAS char*)(F.lds + RING_OFF);
    for (int it = F.vcu; it < 256 + 128; it += F.G) {
        const int lane = lane_id();
        int head, tok0, nwt, NT, qrel; bool masked; size_t krow, crow_; int kv;
        if (it < 256) {
            const int hp = it & 1, qb = (it >> 1) & 15, b = it >> 6; kv = (it >> 5) & 1;
            head = kv * 4 + hp * 2 + (wid >> 2);
            tok0 = M_CTX + b * L_LAT + qb * 128 + (wid & 3) * 32;
            const int kstart = qb == 0 ? 0 : (qb - 1) * 128, kend = qb == 15 ? L_LAT : (qb + 2) * 128; nwt = (kend - kstart) / 64; NT = nwt + 4;
            krow = (size_t)M_CTX + (size_t)b * L_LAT + kstart; crow_ = (size_t)b * 256; masked = true; qrel = qb * 128 + (wid & 3) * 32 - kstart;
        } else {
            const int ci = it - 256, b = ci >> 3; head = ci & 7; kv = head >> 2;
            tok0 = b * L_CTX + wid * 32; krow = (size_t)b * L_CTX; crow_ = 0; nwt = 4; NT = 4; masked = false; qrel = 0;
        }
        const float sinkl = inp(I_SINK)[head] * 1.4426950408889634f;
        att::attn_item(Qb + (size_t)tok0 * DM + head * HD, Kb + krow * KVW + kv * HD, Vb + krow * KVW + kv * HD,
                       CK + crow_ * KVW + kv * HD, CV + crow_ * KVW + kv * HD, nwt, NT, masked, qrel, sinkl, AH + (size_t)tok0 * KMIX + head * HD, lds, wid, lane);
    }
}


namespace hy {
typedef float f32x2 __attribute__((ext_vector_type(2)));
__device__ __forceinline__ f32x2 cmul(f32x2 a, f32x2 b) { return (f32x2){a.x * b.x - a.y * b.y, a.x * b.y + a.y * b.x}; }
template <bool INV> __device__ __forceinline__ f32x2 muli(f32x2 a) { return INV ? (f32x2){-a.y, a.x} : (f32x2){a.y, -a.x}; }
template <bool INV> __device__ __forceinline__ void dft8(f32x2 (&a)[8]) {
    const float r2 = 0.70710678118654752f;
    const f32x2 s0 = a[0] + a[4], d0 = a[0] - a[4], s1 = a[1] + a[5], d1 = a[1] - a[5], s2 = a[2] + a[6], d2 = a[2] - a[6], s3 = a[3] + a[7], d3 = a[3] - a[7];
    const f32x2 t0 = s0 + s2, t1 = s0 - s2, t2 = s1 + s3, t3 = muli<INV>(s1 - s3);
    a[0] = t0 + t2; a[4] = t0 - t2; a[2] = t1 + t3; a[6] = t1 - t3;
    const f32x2 e1 = INV ? (f32x2){(d1.x - d1.y) * r2, (d1.x + d1.y) * r2} : (f32x2){(d1.x + d1.y) * r2, (d1.y - d1.x) * r2};
    const f32x2 e3 = INV ? (f32x2){(-d3.x - d3.y) * r2, (d3.x - d3.y) * r2} : (f32x2){(d3.y - d3.x) * r2, (-d3.x - d3.y) * r2};
    const f32x2 e2 = muli<INV>(d2);
    const f32x2 u0 = d0 + e2, u1 = d0 - e2, u2 = e1 + e3, u3 = muli<INV>(e1 - e3);
    a[1] = u0 + u2; a[5] = u0 - u2; a[3] = u1 + u3; a[7] = u1 - u3;
}
template <bool INV> __device__ __forceinline__ void twiddle(f32x2 (&a)[8], float u) {
    const float c = __builtin_amdgcn_cosf(u), s = __builtin_amdgcn_sinf(u);
    const f32x2 w1 = (f32x2){c, INV ? s : -s};
    const f32x2 w2 = cmul(w1, w1), w3 = cmul(w2, w1), w4 = cmul(w2, w2), w5 = cmul(w4, w1), w6 = cmul(w3, w3), w7 = cmul(w4, w3);
    a[1] = cmul(a[1], w1); a[2] = cmul(a[2], w2); a[3] = cmul(a[3], w3); a[4] = cmul(a[4], w4); a[5] = cmul(a[5], w5); a[6] = cmul(a[6], w6); a[7] = cmul(a[7], w7);
}
__device__ __forceinline__ int layB(int e) { return e + (e >> 3); }
struct SyncWG { __device__ __forceinline__ void operator()() const { __syncthreads(); } };
struct SyncWave { __device__ __forceinline__ void operator()() const { asm volatile("s_waitcnt lgkmcnt(0)" ::: "memory"); } };
template <int NP, int MODE, class Sync>
__device__ __forceinline__ void fft_core(f32x2 (&a)[8], int i, LAS f32x2* C, LAS f32x2* B, f32x4* Hg, Sync sync) {
    constexpr int N = 1 << (3 * NP), Q0 = N / 8;
    dft8<false>(a); twiddle<false>(a, (float)i * (1.0f / N));
#pragma unroll
    for (int r = 0; r < 8; ++r) C[layB(i + Q0 * r)] = a[r];
    sync();
    if constexpr (NP == 4) {
        const int j = i & 63, e0 = (i >> 6) * 512 + j;
#pragma unroll
        for (int m = 0; m < 8; ++m) a[m] = C[layB(e0 + 64 * m)];
        dft8<false>(a); twiddle<false>(a, (float)j * (1.0f / 512));
#pragma unroll
        for (int r = 0; r < 8; ++r) C[layB(e0 + 64 * r)] = a[r];
        sync();
    }
    {
        const int j = i & 7, e0 = (i >> 3) * 64 + j;
#pragma unroll
        for (int m = 0; m < 8; ++m) a[m] = C[layB(e0 + 8 * m)];
        dft8<false>(a); twiddle<false>(a, (float)j * (1.0f / 64));
#pragma unroll
        for (int r = 0; r < 8; ++r) B[layB(e0 + 8 * r)] = a[r];
        sync();
    }
#pragma unroll
    for (int m = 0; m < 8; ++m) a[m] = B[9 * i + m];
    dft8<false>(a);
    if constexpr (MODE == 1) {
        const float sc = 1.0f / N;
#pragma unroll
        for (int mm = 0; mm < 4; ++mm) Hg[mm * Q0] = (f32x4){a[2 * mm].x * sc, a[2 * mm].y * sc, a[2 * mm + 1].x * sc, a[2 * mm + 1].y * sc};
    } else {
#pragma unroll
        for (int mm = 0; mm < 4; ++mm) { const f32x4 h = Hg[mm * Q0]; a[2 * mm] = cmul(a[2 * mm], (f32x2){h.x, h.y}); a[2 * mm + 1] = cmul(a[2 * mm + 1], (f32x2){h.z, h.w}); }
        dft8<true>(a);
#pragma unroll
        for (int m = 0; m < 8; ++m) B[9 * i + m] = a[m];
        sync();
        {
            const int j = i & 7, e0 = (i >> 3) * 64 + j;
#pragma unroll
            for (int r = 0; r < 8; ++r) a[r] = B[layB(e0 + 8 * r)];
            twiddle<true>(a, (float)j * (1.0f / 64)); dft8<true>(a);
#pragma unroll
            for (int m = 0; m < 8; ++m) C[layB(e0 + 8 * m)] = a[m];
            sync();
        }
        if constexpr (NP == 4) {
            const int j = i & 63, e0 = (i >> 6) * 512 + j;
#pragma unroll
            for (int r = 0; r < 8; ++r) a[r] = C[layB(e0 + 64 * r)];
            twiddle<true>(a, (float)j * (1.0f / 512)); dft8<true>(a);
#pragma unroll
            for (int m = 0; m < 8; ++m) C[layB(e0 + 64 * m)] = a[m];
            sync();
        }
#pragma unroll
        for (int r = 0; r < 8; ++r) a[r] = C[layB(i + Q0 * r)];
        twiddle<true>(a, (float)i * (1.0f / N)); dft8<true>(a);
    }
}
constexpr int BUF_SLOTS_L = 4096 + 512, BUF_SLOTS_C = 512 + 64;

__device__ __forceinline__ float hval(const bf16* HY, size_t base, int t, int L, int col) { return (t >= 0 && t < L) ? bf2f(HY[(size_t)col * M + base + t]) : 0.f; }
struct ConvW { float w0, w1, w2, b; };
__device__ __forceinline__ ConvW convw(int col) { const float* cw = inp(I_CONVW); ConvW w; w.w0 = cw[col]; w.w1 = cw[1536 + col]; w.w2 = cw[3072 + col]; w.b = inp(I_CONVB)[col]; return w; }
__device__ __forceinline__ float sconv(const bf16* HY, size_t base, int t, int L, int col, const ConvW& w) {
    return w.w0 * hval(HY, base, t - 1, L, col) + w.w1 * hval(HY, base, t, L, col) + w.w2 * hval(HY, base, t + 1, L, col) + w.b;
}
template <int NP, class Sync>
__device__ __forceinline__ void conv_item(const unsigned char* ws, int c, size_t base0, size_t base1, int i, LAS f32x2* C, LAS f32x2* B, f32x4* Hg, Sync sync) {
    constexpr int N = 1 << (3 * NP), L = N / 2, Q0 = N / 8;
    const bf16* HY = (const bf16*)(ws + WS_HY);
    const ConvW w1 = convw(512 + c), wv = convw(1024 + c);
    f32x2 a[8]; f32x2 z[4];
#pragma unroll
    for (int m = 0; m < 4; ++m) { const int t = i + Q0 * m;
        z[m].x = sconv(HY, base0, t, L, 512 + c, w1) * sconv(HY, base0, t, L, 1024 + c, wv);
        z[m].y = sconv(HY, base1, t, L, 512 + c, w1) * sconv(HY, base1, t, L, 1024 + c, wv);
        a[m] = z[m]; a[4 + m] = (f32x2){0.f, 0.f}; }
    fft_core<NP, 0, Sync>(a, i, C, B, Hg, sync);
    const ConvW w0 = convw(c); const float skip = inp(I_SKIP)[c];
    bf16* AH = (bf16*)(ws + WS_AH);
#pragma unroll
    for (int m = 0; m < 4; ++m) { const int t = i + Q0 * m;
        const float y0 = a[m].x + z[m].x * skip, y1 = a[m].y + z[m].y * skip;
        AH[(base0 + t) * KMIX + 1024 + c] = (bf16)f2bf(sconv(HY, base0, t, L, c, w0) * y0);
        AH[(base1 + t) * KMIX + 1024 + c] = (bf16)f2bf(sconv(HY, base1, t, L, c, w0) * y1); }
}
template <int NP, class Sync>
__device__ __forceinline__ void spec_item(const float* FSc, int i, LAS f32x2* C, LAS f32x2* B, f32x4* Hg, Sync sync) {
    constexpr int N = 1 << (3 * NP), Q0 = N / 8;
    f32x2 a[8];
#pragma unroll
    for (int m = 0; m < 8; ++m) a[m] = (f32x2){FSc[i + Q0 * m], 0.f};
    fft_core<NP, 1, Sync>(a, i, C, B, Hg, sync);
}
}

__device__ __forceinline__ void p1_spectra(Frame& F) {
    const int lane = lane_id(), wid = F.wave;
    LAS hy::f32x2* Cl = (LAS hy::f32x2*)(F.lds + RING_OFF); LAS hy::f32x2* Bl = Cl;
    for (int c = F.vcu; c < HYW; c += F.G) {
        hy::spec_item<4>((const float*)(F.ws + WS_FSL) + (size_t)c * 4096, wid * 64 + lane, Cl, Bl, (f32x4*)(F.ws + WS_HL) + (size_t)c * 2048 + wid * 64 + lane, hy::SyncWG{});
        __syncthreads();
    }
    LAS hy::f32x2* Cw = (LAS hy::f32x2*)(F.lds + RING_OFF) + wid * hy::BUF_SLOTS_C; LAS hy::f32x2* Bw = Cw;
    for (int g = F.vcu; g < HYW / 8; g += F.G) {
        const int c = g * 8 + wid;
        hy::spec_item<3>((const float*)(F.ws + WS_FSC) + (size_t)c * 512, lane, Cw, Bw, (f32x4*)(F.ws + WS_HC) + (size_t)c * 256 + lane, hy::SyncWave{});
    }
    __syncthreads();
}
__device__ __forceinline__ void p3_hyena(Frame& F) {
    const int wid = F.wave;
    LAS hy::f32x2* Cl = (LAS hy::f32x2*)(F.lds + RING_OFF); LAS hy::f32x2* Bl = Cl;
    for (int it = F.vcu; it < HYW * 2; it += F.G) {
        const int lane = lane_id(), c = it >> 1, pair = it & 1;
        const size_t base0 = (size_t)M_CTX + (size_t)(2 * pair) * L_LAT;
        hy::conv_item<4>(F.ws, c, base0, base0 + L_LAT, wid * 64 + lane, Cl, Bl, (f32x4*)(F.ws + WS_HL) + (size_t)c * 2048 + wid * 64 + lane, hy::SyncWG{});
        __syncthreads();
    }
    LAS hy::f32x2* Cw = (LAS hy::f32x2*)(F.lds + RING_OFF) + wid * hy::BUF_SLOTS_C; LAS hy::f32x2* Bw = Cw;
    for (int c = F.vcu; c < HYW; c += F.G) {
        const int lane = lane_id();
        const size_t base0 = (size_t)(2 * wid) * L_CTX;
        hy::conv_item<3>(F.ws, c, base0, base0 + L_CTX, lane, Cw, Bw, (f32x4*)(F.ws + WS_HC) + (size_t)c * 256 + lane, hy::SyncWave{});
    }
    __syncthreads();
}

__device__ __forceinline__ void p6_rows(Frame& F, const Args& A) {
    const int L_lane = lane_id();
    const int gw = F.vcu * NWAVES + F.wave, NGW = F.G * NWAVES;
    const float* MIX = (const float*)(F.ws + WS_F32); const float* MOD = (const float*)(F.ws + WS_MOD); bf16* XN = (bf16*)(F.ws + WS_XN);
    for (int m = gw; m < M; m += NGW) {
        const float* mod = MOD + (size_t)mod_row(m) * NMOD;
        const f32x4* xr = (const f32x4*)xrow_ptr(A, m) + L_lane; const f32x4* mr = (const f32x4*)(MIX + (size_t)m * DM) + L_lane;
        f32x4 v[4]; float s = 0.f;
#pragma unroll
        for (int j = 0; j < 4; ++j) { v[j] = mr[64 * j]; s += (v[j].x * v[j].x + v[j].y * v[j].y) + (v[j].z * v[j].z + v[j].w * v[j].w); }
        const float rstd = 1.0f / sqrtf(wave_sum(s) * (1.0f / DM) + EPS);
        float s2 = 0.f;
#pragma unroll
        for (int j = 0; j < 4; ++j) { const int c = 4 * L_lane + 256 * j;
            const f32x4 g1 = *(const f32x4*)(mod + 2 * DM + c), wp = *(const f32x4*)(inp(I_NMPOST) + c);
            v[j] = xr[64 * j] + g1 * (v[j] * rstd * wp);
            s2 += (v[j].x * v[j].x + v[j].y * v[j].y) + (v[j].z * v[j].z + v[j].w * v[j].w);
            *(f32x4*)(F.out + (size_t)m * DM + c) = v[j]; }
        const float rstd2 = 1.0f / sqrtf(wave_sum(s2) * (1.0f / DM) + EPS);
        unsigned long long* o8 = (unsigned long long*)(XN + (size_t)m * DM) + L_lane;
#pragma unroll
        for (int j = 0; j < 4; ++j) { const int c = 4 * L_lane + 256 * j;
            const f32x4 sh2 = *(const f32x4*)(mod + 3 * DM + c), sc2 = *(const f32x4*)(mod + 4 * DM + c), wp = *(const f32x4*)(inp(I_NFPRE) + c);
            const f32x4 hh = v[j] * rstd2 * wp * (1.0f + sc2) + sh2;
            o8[64 * j] = (unsigned long long)pk2(hh.x, hh.y) | ((unsigned long long)pk2(hh.z, hh.w) << 32); }
    }
}
__device__ __forceinline__ void p9_rows(Frame& F, const Args& A) {
    const int L_lane = lane_id();
    const int gw = F.vcu * NWAVES + F.wave, NGW = F.G * NWAVES;
    const float* FF = (const float*)(F.ws + WS_F32); const float* MOD = (const float*)(F.ws + WS_MOD);
    for (int m = gw; m < M; m += NGW) {
        const float* mod = MOD + (size_t)mod_row(m) * NMOD;
        const f32x4* fr = (const f32x4*)(FF + (size_t)m * DM) + L_lane;
        f32x4 v[4]; float s = 0.f;
#pragma unroll
        for (int j = 0; j < 4; ++j) { v[j] = fr[64 * j]; s += (v[j].x * v[j].x + v[j].y * v[j].y) + (v[j].z * v[j].z + v[j].w * v[j].w); }
        const float rstd = 1.0f / sqrtf(wave_sum(s) * (1.0f / DM) + EPS);
#pragma unroll
        for (int j = 0; j < 4; ++j) { const int c = 4 * L_lane + 256 * j;
            const f32x4 g2 = *(const f32x4*)(mod + 5 * DM + c), wp = *(const f32x4*)(inp(I_NFPOST) + c);
            float* o = F.out + (size_t)m * DM + c; *(f32x4*)o = *(const f32x4*)o + g2 * (v[j] * rstd * wp); }
    }
}

__global__ void __launch_bounds__(NTHR, 2) fwd_kernel(const Args args) {
    extern __shared__ __attribute__((aligned(16))) unsigned char lds[];
    Frame F;
    F.lds = (LAS unsigned char*)lds;
    F.MISC = (volatile LAS unsigned*)(F.lds + MISC_OFF);
    F.wave = __builtin_amdgcn_readfirstlane(threadIdx.x >> 6);
    F.G = gridDim.x; { const int bx = blockIdx.x; F.vcu = (F.G % 8 == 0) ? (bx % 8) * (F.G / 8) + bx / 8 : bx; }
    F.out = args.out; F.ws = args.ws;
    F.ctl = (gu32*)(F.ws + WS_CTL);
    for (int u = F.wave * 64 + lane_id(); u < (LDS_BYTES - LDSCTL_OFF) / 4; u += NTHR) ((LAS unsigned*)(F.lds + LDSCTL_OFF))[u] = 0u;
    __syncthreads();
    XcdBarrier bar; bar.bar = (unsigned*)(F.ctl + CW_BAR) + args.li * XCD_BAR_WORDS; bar.x = 0; bar.st = nullptr;
    if (N_LAUNCHES == 1) bar = xcd_barrier_post((unsigned*)(F.ctl + CW_BAR) + args.li * XCD_BAR_WORDS, F.MISC + 8, F.wave);
#define GRID_BAR() do { if (N_LAUNCHES == 1) xcd_barrier(bar, F.wave); } while (0)
    const int lo = args.ph_lo, hi = args.ph_hi;
#define IN(k) (lo <= (k) && (k) < hi)
#define BOTH(k) (IN(k) && IN((k) + 1))
    bf16* const XN = (bf16*)(F.ws + WS_XN);
    if (IN(0)) { p0_prologue(F, args); if (BOTH(0)) GRID_BAR(); }
    if (IN(1)) { p1_spectra(F); p1_rows(F, args); if (BOTH(1)) GRID_BAR(); }
    if (IN(2)) {
        pg8::Gemm g{XN, (const bf16*)(F.ws + WS_W1), M, NIN - 3 * HYW, DM, (const bf16*)(F.ws + WS_W1) + (size_t)(NIN - 3 * HYW) * DM, XN}; pg8::DualOrder S; S.init(M, NIN - 3 * HYW, 3 * HYW, M, F.G, (int)blockIdx.x);
        pg8::EpiIn E{(bf16*)(F.ws + WS_Q), (bf16*)(F.ws + WS_K), (bf16*)(F.ws + WS_V), (bf16*)(F.ws + WS_HY), (bf16*)(F.ws + WS_GT),
                     F.out + OUT_NEWK, F.out + OUT_NEWV, inp(I_BGATE), (const float*)(F.ws + WS_ROPE)};
        pg8::gemm_phase<pg8::EpiIn, pg8::DualOrder, true, true>(F.lds + RING_OFF, g, S, E, F.wave);
        if (BOTH(2)) GRID_BAR();
    }
    if (IN(3)) { p3_attention(F); __syncthreads(); p3_hyena(F); if (BOTH(3)) GRID_BAR(); }
    if (IN(4)) {
        pg8::Gemm g{(const bf16*)(F.ws + WS_AH), (const bf16*)(F.ws + WS_W2), M, DM, KMIX}; pg8::StaticOrder S; S.init(M, DM, F.G, (int)blockIdx.x);
        pg8::EpiMerge E{(const bf16*)(F.ws + WS_GT), (bf16*)(F.ws + WS_MG)};
        pg8::gemm_phase<pg8::EpiMerge, pg8::StaticOrder, false, true>(F.lds + RING_OFF, g, S, E, F.wave);
        if (BOTH(4)) GRID_BAR();
    }
    if (IN(5)) {
        pg8::Gemm g{(const bf16*)(F.ws + WS_MG), (const bf16*)(F.ws + WS_W3), M, DM, DM}; pg8::StaticOrder S; S.init(M, DM, F.G, (int)blockIdx.x);
        pg8::EpiF32 E{(float*)(F.ws + WS_F32), DM};
        pg8::gemm_phase<pg8::EpiF32, pg8::StaticOrder, false, true>(F.lds + RING_OFF, g, S, E, F.wave);
        if (BOTH(5)) GRID_BAR();
    }
    if (IN(6)) { p6_rows(F, args); if (BOTH(6)) GRID_BAR(); }
    if (IN(7)) {
        pg8::Gemm g{XN, (const bf16*)(F.ws + WS_W4), M, NUP, DM}; pg8::StaticOrder S; S.init(M, NUP, F.G, (int)blockIdx.x);
        pg8::EpiSwiGLU E{(bf16*)(F.ws + WS_ACT), DFF};
        pg8::gemm_phase<pg8::EpiSwiGLU, pg8::StaticOrder, true, true>(F.lds + RING_OFF, g, S, E, F.wave);
        if (BOTH(7)) GRID_BAR();
    }
    if (IN(8)) {
        pg8::Gemm g{(const bf16*)(F.ws + WS_ACT), (const bf16*)(F.ws + WS_W5), M, DM, DFF}; pg8::StaticOrder S; S.init(M, DM, F.G, (int)blockIdx.x);
        pg8::EpiF32 E{(float*)(F.ws + WS_F32), DM};
        pg8::gemm_phase<pg8::EpiF32, pg8::StaticOrder, false, true>(F.lds + RING_OFF, g, S, E, F.wave);
        if (BOTH(8)) GRID_BAR();
    }
    if (IN(9)) { p9_rows(F, args); }
#undef IN
#undef BOTH
}

extern "C" void kernel_launch(void* const* d_in, const int* in_sizes, int n_in, void* d_out, int out_size, void* d_ws, size_t ws_size, hipStream_t stream) {
    static int grid = 0;
    if (grid == 0) {
        if (n_in != 33 || out_size != M * DM + 2 * M_CTX * KVW || ws_size < WS_END) { fprintf(stderr, "kernel_launch: unexpected sizes n_in %d out %d ws %zu\n", n_in, out_size, ws_size); grid = -1; return; }
        int dev = 0, cus = 0, per_cu = 0;
        if (hipGetDevice(&dev) != hipSuccess || hipDeviceGetAttribute(&cus, hipDeviceAttributeMultiprocessorCount, dev) != hipSuccess) { grid = -1; return; }
        if (hipFuncSetAttribute((const void*)fwd_kernel, hipFuncAttributeMaxDynamicSharedMemorySize, LDS_BYTES) != hipSuccess) { fprintf(stderr, "kernel_launch: hipFuncSetAttribute failed\n"); grid = -1; return; }
        if (hipOccupancyMaxActiveBlocksPerMultiprocessor(&per_cu, (const void*)fwd_kernel, NTHR, LDS_BYTES) != hipSuccess || per_cu < 1) { fprintf(stderr, "kernel_launch: occupancy query says %d\n", per_cu); }
        (void)hipGetLastError();
        grid = cus;
        if (grid != 256) fprintf(stderr, "kernel_launch: %d CUs (expected 256)\n", grid);
    }
    if (grid < 0) return;
    (void)hipMemsetAsync((char*)d_ws + WS_CTL, 0, CTL_ZERO_BYTES, stream);
    Args a{};
    for (int i = 0; i < 33; ++i) a.in[i] = (const float*)d_in[i];
    a.out = (float*)d_out; a.ws = (unsigned char*)d_ws;
    if (PROBE_PHASE >= 0) { a.ph_lo = PROBE_PHASE; a.ph_hi = PROBE_PHASE + 1; a.li = 1; hipLaunchKernelGGL(fwd_kernel, dim3(grid), dim3(NTHR), LDS_BYTES, stream, a); }
    for (int li = 0; li < N_LAUNCHES; ++li) {
        a.ph_lo = (N_LAUNCHES == 1) ? 0 : li; a.ph_hi = (N_LAUNCHES == 1) ? N_PHASES : li + 1; a.li = li;
        hipLaunchKernelGGL(fwd_kernel, dim3(grid), dim3(NTHR), LDS_BYTES, stream, a);
    }
}
```

```cpp
#include <hip/hip_runtime.h>
#include <cstdio>
#include <cstdint>
__device__ __forceinline__ int lane_id() { int l; asm volatile("v_mbcnt_lo_u32_b32 %0, -1, 0\n\tv_mbcnt_hi_u32_b32 %0, -1, %0" : "=v"(l)); return l; }
namespace pg8 {
#define PG8_LAS __attribute__((address_space(3)))
typedef unsigned short bf16_t;
typedef short bf16x8 __attribute__((ext_vector_type(8)));
typedef float f32x4 __attribute__((ext_vector_type(4)));
typedef unsigned u32x4 __attribute__((ext_vector_type(4)));
constexpr int BM = 256, BK = 64, HALF = 128, HTB = HALF * BK * 2  , STAGE_BYTES = 8 * HTB, NXCD = 8, WGM = 8;

__host__ __device__ __forceinline__ int lds_byte(int r, int c) { const int st = (r >> 4) * 2 + (c >> 5), rr = r & 15, cc = c & 31, ob = rr * 64 + cc * 2; return st * 1024 + (ob ^ (((ob >> 9) & 1) << 5)); }
__host__ __device__ __forceinline__ void stage_rc(int b, int& R, int& C) { const int st = b / 1024, sb = b % 1024, swz = sb ^ (((sb >> 9) & 1) << 5); R = (st >> 1) * 16 + swz / 64; C = (st & 1) * 32 + (swz % 64) / 2; }
__host__ __device__ __forceinline__ int perm32(int rho) { const int n = rho >> 4, i = rho & 15; return 8 * (i >> 2) + 4 * n + (i & 3); }

struct Unit { int pm, pn, kind; };
struct Gemm { const bf16_t* A; const bf16_t* Bt; int M, N, K; const bf16_t* A2; const bf16_t* Bt2; };

struct StaticOrder {
    int nM, nN, nwg, G, c;
    __host__ __device__ void init(int M, int N, int G_, int c_) { nM = M / BM; nN = N / BM; nwg = nM * nN; G = G_; c = c_; }
    __host__ __device__ bool next(int i, Unit& u) const { const long L = (long)i * G + c; if (L >= nwg) return false; map((int)L, u); return true; }
    __host__ __device__ bool map(int L, Unit& u) const {
        u.kind = 0;
        int wgid = L; { const int q = nwg / NXCD, r = nwg % NXCD, xcd = wgid % NXCD, off = wgid / NXCD; wgid = (xcd < r ? xcd * (q + 1) : r * (q + 1) + (xcd - r) * q) + off; }
        const int nig = WGM * nN, gid = wgid / nig, fm = gid * WGM, gsz = (nM - fm) < WGM ? (nM - fm) : WGM;
        u.pm = fm + ((wgid % nig) % gsz); u.pn = (wgid % nig) / gsz; return true;
    }
    __device__ __forceinline__ void a_ready(const Unit&) const {}
    __device__ __forceinline__ void done(const Unit&) const {}
};


struct DualOrder {
    StaticOrder s0, s1; int G, c;
    __host__ __device__ void init(int M0, int N0, int M1, int N1, int G_, int c_) { s0.init(M0, N0, G_, c_); s1.init(M1, N1, G_, c_); G = G_; c = c_; }
    __host__ __device__ bool next(int i, Unit& u) const {
        const long L = (long)i * G + c;
        if (L < s1.nwg) { s1.map((int)L, u); u.kind = 1; return true; }
        if (L - s1.nwg < s0.nwg) { s0.map((int)(L - s1.nwg), u); return true; }
        return false; }
    __device__ __forceinline__ void a_ready(const Unit&) const {}
    __device__ __forceinline__ void done(const Unit&) const {}
};

__device__ __forceinline__ unsigned cvt_pk_bf16(float lo, float hi) { unsigned r; asm volatile("v_cvt_pk_bf16_f32 %0, %1, %2" : "=v"(r) : "v"(lo), "v"(hi)); return r; }
typedef float f32x2 __attribute__((ext_vector_type(2)));
typedef unsigned u32x2 __attribute__((ext_vector_type(2)));
__device__ __forceinline__ float bf_lo(unsigned w) { return __uint_as_float(w << 16); }
__device__ __forceinline__ float bf_hi(unsigned w) { return __uint_as_float(w & 0xffff0000u); }
__device__ __forceinline__ float sigmoid_f(float x) { return __builtin_amdgcn_rcpf(1.0f + __builtin_amdgcn_exp2f(-1.4426950408889634f * x)); }

constexpr int M_CTX = 4096;
constexpr float QSCALE = 0.088388347648318440f * 1.4426950408889634f;

struct EpiF32 {
    static constexpr bool PERM = false, AFTER_DRAIN = false; static constexpr int MID_T = -1;
    float* C; int ldc;
    __device__ __forceinline__ void mid(f32x4 (&acc)[2][2][4][2], const Unit& u, int wr, int wc, int fr, int fq) const {}
    __device__ __forceinline__ void operator()(const f32x4 (&acc)[2][2][4][2], const Unit& u, int wr, int wc, int fr, int fq) const {
        const int row0 = u.pm * BM + wr * 64 + fr, col0 = u.pn * BM + wc * 32 + 4 * fq;
#pragma unroll
        for (int ai = 0; ai < 2; ++ai)
#pragma unroll
            for (int m = 0; m < 4; ++m) { float* rowp = C + (size_t)(row0 + ai * HALF + m * 16) * ldc + col0;
#pragma unroll
                for (int bj = 0; bj < 2; ++bj)
#pragma unroll
                    for (int n = 0; n < 2; ++n) *(f32x4*)(rowp + bj * HALF + n * 16) = acc[ai][bj][m][n]; }
    }
};

struct EpiIn {
    static constexpr bool PERM = true, AFTER_DRAIN = false; static constexpr int MID_T = -1;
    bf16_t *Q, *Kb, *Vb, *HY, *GT; float *newk, *newv; const float* bgate; const float* rope;
    __device__ __forceinline__ void mid(f32x4 (&acc)[2][2][4][2], const Unit& u, int wr, int wc, int fr, int fq) const {}
    __device__ __forceinline__ void operator()(const f32x4 (&acc)[2][2][4][2], const Unit& u, int wr, int wc, int fr, int fq) const {
        const int pn = u.pn, rowb = u.pm * BM + wr * 64 + fr;
        if (u.kind == 1) {
            const int tok0 = pn * BM + wc * 32 + 8 * fq;
#pragma unroll
            for (int ai = 0; ai < 2; ++ai)
#pragma unroll
                for (int m = 0; m < 4; ++m) {
                    bf16_t* hp = HY + (size_t)(rowb + ai * HALF + m * 16) * 12288 + tok0;
#pragma unroll
                    for (int bj = 0; bj < 2; ++bj) { const f32x4 v0 = acc[ai][bj][m][0], v1 = acc[ai][bj][m][1];
                        u32x4 w; w.x = cvt_pk_bf16(v0[0], v0[1]); w.y = cvt_pk_bf16(v0[2], v0[3]); w.z = cvt_pk_bf16(v1[0], v1[1]); w.w = cvt_pk_bf16(v1[2], v1[3]);
                        *(u32x4*)(hp + bj * HALF) = w; }
                }
            return;
        }
        const bool latent = u.pm >= (M_CTX / BM);
        if (pn < 5) {
            const int fidx = ((wc & 1) * 4 + fq) * 4, d0 = (wc >> 1) * 64 + fidx;
            const bool isq = pn < 4; const float sc = isq ? QSCALE : 1.0f;
#pragma unroll
            for (int ai = 0; ai < 2; ++ai)
#pragma unroll
                for (int m = 0; m < 4; ++m) {
                    const int row = rowb + ai * HALF + m * 16;
                    f32x4 cs0 = (f32x4){1.f, 0.f, 1.f, 0.f}, cs1 = cs0;
                    if (latent) { const int t = (row - M_CTX) & 2047, pos = (wc >> 1) ? (t & 63) : (t >> 6);
                        const f32x4* rp = (const f32x4*)(rope + (size_t)(pos * 32 + fidx) * 2); cs0 = rp[0]; cs1 = rp[1]; }
#pragma unroll
                    for (int bj = 0; bj < 2; ++bj) {
                        const f32x4 x1 = acc[ai][bj][m][0], x2 = acc[ai][bj][m][1];
                        f32x4 o1, o2;
                        o1[0] = (x1[0] * cs0[0] - x2[0] * cs0[1]) * sc; o2[0] = (x1[0] * cs0[1] + x2[0] * cs0[0]) * sc;
                        o1[1] = (x1[1] * cs0[2] - x2[1] * cs0[3]) * sc; o2[1] = (x1[1] * cs0[3] + x2[1] * cs0[2]) * sc;
                        o1[2] = (x1[2] * cs1[0] - x2[2] * cs1[1]) * sc; o2[2] = (x1[2] * cs1[1] + x2[2] * cs1[0]) * sc;
                        o1[3] = (x1[3] * cs1[2] - x2[3] * cs1[3]) * sc; o2[3] = (x1[3] * cs1[3] + x2[3] * cs1[2]) * sc;
                        u32x2 w1, w2; w1.x = cvt_pk_bf16(o1[0], o1[1]); w1.y = cvt_pk_bf16(o1[2], o1[3]); w2.x = cvt_pk_bf16(o2[0], o2[1]); w2.y = cvt_pk_bf16(o2[2], o2[3]);
                        if (isq) { bf16_t* p = Q + (size_t)row * 1024 + (pn * 2 + bj) * 128 + d0; *(u32x2*)p = w1; *(u32x2*)(p + 32) = w2; }
                        else { bf16_t* p = Kb + (size_t)row * 256 + bj * 128 + d0; *(u32x2*)p = w1; *(u32x2*)(p + 32) = w2;
                            if (!latent) { float* q = newk + (size_t)row * 256 + bj * 128 + d0; *(f32x4*)q = o1; *(f32x4*)(q + 32) = o2; } }
                    }
                }
        } else {
            const int cin = wc * 32 + 8 * fq;
            bf16_t* base; int ld, col0;
            if (pn == 5) { base = Vb; ld = 256; col0 = 0; } else { base = GT; ld = 2048; col0 = (pn - 6) * BM; }
            f32x4 bv[2][2];
#pragma unroll
            for (int bj = 0; bj < 2; ++bj)
#pragma unroll
                for (int n = 0; n < 2; ++n) bv[bj][n] = (pn >= 6) ? *(const f32x4*)(bgate + col0 + bj * HALF + cin + 4 * n) : (f32x4){0.f, 0.f, 0.f, 0.f};
#pragma unroll
            for (int ai = 0; ai < 2; ++ai)
#pragma unroll
                for (int m = 0; m < 4; ++m) {
                    const int row = rowb + ai * HALF + m * 16;
#pragma unroll
                    for (int bj = 0; bj < 2; ++bj) {
                        f32x4 v0 = acc[ai][bj][m][0] + bv[bj][0], v1 = acc[ai][bj][m][1] + bv[bj][1];
                        if (pn >= 6) {
#pragma unroll
                            for (int j = 0; j < 4; ++j) { v0[j] = sigmoid_f(v0[j]); v1[j] = sigmoid_f(v1[j]); } }
                        u32x4 w; w.x = cvt_pk_bf16(v0[0], v0[1]); w.y = cvt_pk_bf16(v0[2], v0[3]); w.z = cvt_pk_bf16(v1[0], v1[1]); w.w = cvt_pk_bf16(v1[2], v1[3]);
                        *(u32x4*)(base + (size_t)row * ld + col0 + bj * HALF + cin) = w;
                        if (pn == 5 && !latent) { float* q = newv + (size_t)row * 256 + bj * HALF + cin; *(f32x4*)q = v0; *(f32x4*)(q + 4) = v1; }
                    }
                }
        }
    }
};

struct EpiMerge {
    static constexpr bool PERM = true, AFTER_DRAIN = false; static constexpr int MID_T = 16;
    const bf16_t* GT; bf16_t* MG;
    __device__ __forceinline__ void mid(f32x4 (&acc)[2][2][4][2], const Unit& u, int wr, int wc, int fr, int fq) const {
        int rowb = u.pm * BM + wr * 64 + fr, colb = u.pn * BM + wc * 32 + 8 * fq;
        asm volatile("" : "+v"(rowb), "+v"(colb));
#pragma unroll
        for (int ai = 0; ai < 2; ++ai)
#pragma unroll
            for (int m = 0; m < 4; ++m) {
                const bf16_t* g = GT + (size_t)(rowb + ai * HALF + m * 16) * 2048 + colb;
#pragma unroll
                for (int bj = 0; bj < 2; ++bj) {
                    const u32x4 ga = *(const u32x4*)(g + bj * HALF), gh = *(const u32x4*)(g + 1024 + bj * HALF);
                    f32x4& a0 = acc[ai][bj][m][0]; f32x4& a1 = acc[ai][bj][m][1];
                    a0[0] *= bf_lo(ga.x) * __builtin_amdgcn_rcpf(bf_lo(gh.x)); a0[1] *= bf_hi(ga.x) * __builtin_amdgcn_rcpf(bf_hi(gh.x));
                    a0[2] *= bf_lo(ga.y) * __builtin_amdgcn_rcpf(bf_lo(gh.y)); a0[3] *= bf_hi(ga.y) * __builtin_amdgcn_rcpf(bf_hi(gh.y));
                    a1[0] *= bf_lo(ga.z) * __builtin_amdgcn_rcpf(bf_lo(gh.z)); a1[1] *= bf_hi(ga.z) * __builtin_amdgcn_rcpf(bf_hi(gh.z));
                    a1[2] *= bf_lo(ga.w) * __builtin_amdgcn_rcpf(bf_lo(gh.w)); a1[3] *= bf_hi(ga.w) * __builtin_amdgcn_rcpf(bf_hi(gh.w));
                }
            }
    }
    __device__ __forceinline__ void operator()(const f32x4 (&acc)[2][2][4][2], const Unit& u, int wr, int wc, int fr, int fq) const {
        int rowb = u.pm * BM + wr * 64 + fr, colb = u.pn * BM + wc * 32 + 8 * fq;
        asm volatile("" : "+v"(rowb), "+v"(colb));
#pragma unroll
        for (int ai = 0; ai < 2; ++ai)
#pragma unroll
            for (int m = 0; m < 4; ++m) {
                const size_t ro = (size_t)(rowb + ai * HALF + m * 16);
#pragma unroll
                for (int bj = 0; bj < 2; ++bj) {
                    const u32x4 gh = *(const u32x4*)(GT + ro * 2048 + 1024 + colb + bj * HALF);
                    const f32x4 a0 = acc[ai][bj][m][0], a1 = acc[ai][bj][m][1];
                    u32x4 w; w.x = cvt_pk_bf16(a0[0] * bf_lo(gh.x), a0[1] * bf_hi(gh.x)); w.y = cvt_pk_bf16(a0[2] * bf_lo(gh.y), a0[3] * bf_hi(gh.y));
                    w.z = cvt_pk_bf16(a1[0] * bf_lo(gh.z), a1[1] * bf_hi(gh.z)); w.w = cvt_pk_bf16(a1[2] * bf_lo(gh.w), a1[3] * bf_hi(gh.w));
                    *(u32x4*)(MG + ro * 1024 + colb + bj * HALF) = w;
                }
            }
    }
};

struct EpiSwiGLU {
    static constexpr bool PERM = true, AFTER_DRAIN = false; static constexpr int MID_T = -1;
    bf16_t* ACT; int ld;
    __device__ __forceinline__ void mid(f32x4 (&acc)[2][2][4][2], const Unit& u, int wr, int wc, int fr, int fq) const {}
    __device__ __forceinline__ void operator()(const f32x4 (&acc)[2][2][4][2], const Unit& u, int wr, int wc, int fr, int fq) const {
        const int rowb = u.pm * BM + wr * 64 + fr, colb = u.pn * HALF + wc * 32 + 8 * fq;
#pragma unroll
        for (int ai = 0; ai < 2; ++ai)
#pragma unroll
            for (int m = 0; m < 4; ++m) {
                float o[8];
#pragma unroll
                for (int n = 0; n < 2; ++n)
#pragma unroll
                    for (int j = 0; j < 4; ++j) { const float g = acc[ai][0][m][n][j], up = acc[ai][1][m][n][j]; o[n * 4 + j] = g * sigmoid_f(g) * up; }
                u32x4 w; w.x = cvt_pk_bf16(o[0], o[1]); w.y = cvt_pk_bf16(o[2], o[3]); w.z = cvt_pk_bf16(o[4], o[5]); w.w = cvt_pk_bf16(o[6], o[7]);
                *(u32x4*)(ACT + (size_t)(rowb + ai * HALF + m * 16) * ld + colb) = w;
            }
    }
};

template <class Epi, class Sched, bool ALIGN_EPI = false, bool SP2 = false>
__device__ __forceinline__ void gemm_phase(PG8_LAS unsigned char* lds, const Gemm g, const Sched& S, const Epi& E, const int wid) {
    const int lane = lane_id(), tid = wid * 64 + lane, wr = wid >> 2, wc = wid & 3, fr = lane & 15, fq = lane >> 4;
    const int K = g.K, nt = K / BK;
    unsigned voffA[2], voffB[2];
#pragma unroll
    for (int i = 0; i < 2; ++i) { int R, C; stage_rc(tid * 16 + i * 8192, R, C); const int Rb = Epi::PERM ? ((R & ~31) + perm32(R & 31)) : R;
        voffA[i] = (unsigned)(R * K + C) * 2u; voffB[i] = (unsigned)(Rb * K + C) * 2u; }
    const size_t kstep = (size_t)(BK * 2);
    const size_t hstep = (size_t)HALF * K * 2;
    const size_t tstep = 2 * hstep;
    const unsigned ldsw = (unsigned)wid * 1024u;
    const int aoff = lds_byte(wr * 64 + fr, fq * 8), boff = lds_byte(wc * 32 + fr, fq * 8);
#define PG8_SA(b, h) (((b) * 2 + (h)) * HTB)
#define PG8_SB(b, h) ((4 + (b) * 2 + (h)) * HTB)
#define PG8_STAGE(bufoff, gbase, voff) do { _Pragma("unroll") for (int _i = 0; _i < 2; ++_i) \
        __builtin_amdgcn_global_load_lds((const unsigned*)((const char*)(gbase) + (voff)[_i]), (PG8_LAS unsigned*)(lds + (bufoff) + ldsw + _i * 8192), 16, 0, 0); } while (0)
#define PG8_LDA(dst, b, h) do { _Pragma("unroll") for (int m = 0; m < 4; ++m) _Pragma("unroll") for (int k = 0; k < 2; ++k) dst[m][k] = *(const PG8_LAS bf16x8*)(lds + PG8_SA(b, h) + aoff + m * 2048 + k * 1024); } while (0)
#define PG8_LDB(dst, b, h) do { _Pragma("unroll") for (int n = 0; n < 2; ++n) _Pragma("unroll") for (int k = 0; k < 2; ++k) dst[n][k] = *(const PG8_LAS bf16x8*)(lds + PG8_SB(b, h) + boff + n * 2048 + k * 1024); } while (0)
#define PG8_MMA(ai, bj, At, Bt) do { __builtin_amdgcn_s_setprio(1); _Pragma("unroll") for (int m = 0; m < 4; ++m) _Pragma("unroll") for (int n = 0; n < 2; ++n) _Pragma("unroll") for (int k = 0; k < 2; ++k) \
        acc[ai][bj][m][n] = __builtin_amdgcn_mfma_f32_16x16x32_bf16(Bt[n][k], At[m][k], acc[ai][bj][m][n], 0, 0, 0); __builtin_amdgcn_s_setprio(0); } while (0)
#define PG8_WAIT_V(n) asm volatile("s_waitcnt vmcnt(" #n ")" ::: "memory")
#define PG8_WAIT_L(n) asm volatile("s_waitcnt lgkmcnt(" #n ")" ::: "memory")
#define PG8_BAR __builtin_amdgcn_s_barrier()
#define PG8_SCHED __builtin_amdgcn_sched_barrier(0)
    Unit cur, nxt; int ui = 0;
    if (!S.next(0, cur)) return;
    f32x4 acc[2][2][4][2];
#pragma unroll
    for (int a = 0; a < 2; ++a)
#pragma unroll
        for (int b = 0; b < 2; ++b)
#pragma unroll
            for (int m = 0; m < 4; ++m)
#pragma unroll
                for (int n = 0; n < 2; ++n) acc[a][b][m][n] = (f32x4){0.f, 0.f, 0.f, 0.f};
    bf16x8 At[4][2], B0[2][2], B1[2][2];
    const char* cA = (const char*)(cur.kind ? g.A2 : g.A) + (size_t)cur.pm * tstep; const char* cB = (const char*)(cur.kind ? g.Bt2 : g.Bt) + (size_t)cur.pn * tstep;
    S.a_ready(cur);
    if constexpr (SP2) {
        PG8_STAGE(PG8_SB(0, 0), cB, voffB); PG8_STAGE(PG8_SB(0, 1), cB + hstep, voffB); PG8_STAGE(PG8_SA(0, 0), cA, voffA); PG8_STAGE(PG8_SA(0, 1), cA + hstep, voffA);
        if (wr == 1) PG8_BAR;
        PG8_WAIT_V(2); PG8_BAR;
        PG8_STAGE(PG8_SB(1, 0), cB + kstep, voffB); PG8_STAGE(PG8_SA(1, 0), cA + kstep, voffA); PG8_STAGE(PG8_SB(1, 1), cB + hstep + kstep, voffB);
        PG8_WAIT_V(6); PG8_BAR;
    } else {
        PG8_STAGE(PG8_SB(0, 0), cB, voffB); PG8_STAGE(PG8_SA(0, 0), cA, voffA); PG8_STAGE(PG8_SB(0, 1), cB + hstep, voffB); PG8_STAGE(PG8_SA(0, 1), cA + hstep, voffA);
        if (wr == 1) PG8_BAR;
        PG8_WAIT_V(4); PG8_BAR;
        PG8_STAGE(PG8_SB(1, 0), cB + kstep, voffB); PG8_STAGE(PG8_SA(1, 0), cA + kstep, voffA); PG8_STAGE(PG8_SB(1, 1), cB + hstep + kstep, voffB);
        PG8_WAIT_V(6); PG8_BAR;
    }
    for (;;) {
        const bool has_next = S.next(ui + 1, nxt);
        const char* nA = has_next ? (const char*)(nxt.kind ? g.A2 : g.A) + (size_t)nxt.pm * tstep : cA; const char* nB = has_next ? (const char*)(nxt.kind ? g.Bt2 : g.Bt) + (size_t)nxt.pn * tstep : cB;
        for (int t = 0; t < nt; t += 2) {
            if constexpr (Epi::MID_T >= 0) { if (t == Epi::MID_T) E.mid(acc, cur, wr, wc, fr, fq); }
            const bool last = (t == nt - 2);
            const char* a1 = cA + (size_t)(t + 1) * kstep;
            const char* a2 = last ? nA : cA + (size_t)(t + 2) * kstep; const char* b2 = last ? nB : cB + (size_t)(t + 2) * kstep;
            const char* a3 = a2 + kstep; const char* b3 = b2 + kstep;
            if (last && has_next) S.a_ready(nxt);
            if constexpr (SP2) {
            PG8_LDB(B0, 0, 0); PG8_LDB(B1, 0, 1); PG8_SCHED; PG8_LDA(At, 0, 0); PG8_STAGE(PG8_SA(1, 1), a1 + hstep, voffA);
            PG8_WAIT_V(8); PG8_WAIT_L(0); PG8_BAR; PG8_MMA(0, 0, At, B0); PG8_MMA(0, 1, At, B1); PG8_BAR; PG8_SCHED;
            PG8_LDA(At, 0, 1); PG8_STAGE(PG8_SB(0, 0), b2, voffB); PG8_STAGE(PG8_SB(0, 1), b2 + hstep, voffB); PG8_STAGE(PG8_SA(0, 0), a2, voffA);
            PG8_WAIT_V(8); PG8_WAIT_L(0); PG8_BAR; PG8_MMA(1, 0, At, B0); PG8_MMA(1, 1, At, B1); PG8_BAR; PG8_SCHED;
            PG8_LDB(B0, 1, 0); PG8_LDB(B1, 1, 1); PG8_SCHED; PG8_LDA(At, 1, 0); PG8_STAGE(PG8_SA(0, 1), a2 + hstep, voffA);
            PG8_WAIT_V(8); PG8_WAIT_L(0); PG8_BAR; PG8_MMA(0, 0, At, B0); PG8_MMA(0, 1, At, B1); PG8_BAR; PG8_SCHED;
            PG8_LDA(At, 1, 1); PG8_STAGE(PG8_SB(1, 0), b3, voffB); PG8_STAGE(PG8_SB(1, 1), b3 + hstep, voffB); PG8_STAGE(PG8_SA(1, 0), a3, voffA);
            PG8_WAIT_V(8); PG8_WAIT_L(0); PG8_BAR; PG8_MMA(1, 0, At, B0); PG8_MMA(1, 1, At, B1); PG8_BAR; PG8_SCHED;
            } else {
            PG8_LDB(B0, 0, 0); PG8_SCHED; PG8_LDA(At, 0, 0); PG8_STAGE(PG8_SA(1, 1), a1 + hstep, voffA);
            PG8_WAIT_L(8); PG8_BAR; PG8_WAIT_L(0); PG8_MMA(0, 0, At, B0); PG8_BAR; PG8_SCHED;
            PG8_LDB(B1, 0, 1); PG8_STAGE(PG8_SB(0, 0), b2, voffB);
            PG8_BAR; PG8_WAIT_L(0); PG8_MMA(0, 1, At, B1); PG8_BAR;
            PG8_LDA(At, 0, 1); PG8_STAGE(PG8_SA(0, 0), a2, voffA);
            PG8_BAR; PG8_WAIT_L(0); PG8_MMA(1, 0, At, B0); PG8_BAR; PG8_SCHED;
            PG8_STAGE(PG8_SB(0, 1), b2 + hstep, voffB);
            PG8_WAIT_V(6); PG8_BAR; PG8_MMA(1, 1, At, B1); PG8_BAR;
            PG8_LDB(B0, 1, 0); PG8_SCHED; PG8_LDA(At, 1, 0); PG8_STAGE(PG8_SA(0, 1), a2 + hstep, voffA);
            PG8_WAIT_L(8); PG8_BAR; PG8_WAIT_L(0); PG8_MMA(0, 0, At, B0); PG8_BAR; PG8_SCHED;
            PG8_LDB(B1, 1, 1); PG8_STAGE(PG8_SB(1, 0), b3, voffB);
            PG8_BAR; PG8_WAIT_L(0); PG8_MMA(0, 1, At, B1); PG8_BAR;
            PG8_LDA(At, 1, 1); PG8_STAGE(PG8_SA(1, 0), a3, voffA);
            PG8_BAR; PG8_WAIT_L(0); PG8_MMA(1, 0, At, B0); PG8_BAR; PG8_SCHED;
            PG8_STAGE(PG8_SB(1, 1), b3 + hstep, voffB);
            PG8_WAIT_V(6); PG8_BAR; PG8_MMA(1, 1, At, B1); PG8_BAR;
            }
        }
        if constexpr (ALIGN_EPI) { if (wr == 0) PG8_BAR; }
        if constexpr (!Epi::AFTER_DRAIN) { E(acc, cur, wr, wc, fr, fq); S.done(cur); }
        if (!has_next) break;
#pragma unroll
        for (int a = 0; a < 2; ++a)
#pragma unroll
            for (int b = 0; b < 2; ++b)
#pragma unroll
                for (int m = 0; m < 4; ++m)
#pragma unroll
                    for (int n = 0; n < 2; ++n) acc[a][b][m][n] = (f32x4){0.f, 0.f, 0.f, 0.f};
        cur = nxt; cA = nA; cB = nB; ++ui;
        if constexpr (ALIGN_EPI) { if (wr == 1) PG8_BAR; }
    }
    PG8_WAIT_V(0);
    if constexpr (!ALIGN_EPI) { if (wr == 0) PG8_BAR; }
    PG8_BAR;
    if constexpr (Epi::AFTER_DRAIN) { E.fused(acc, cur, wr, wc, fr, fq, lds, wid, lane); S.done(cur); }
#undef PG8_SA
#undef PG8_SB
#undef PG8_STAGE
#undef PG8_LDA
#undef PG8_LDB
#undef PG8_MMA
#undef PG8_WAIT_V
#undef PG8_WAIT_L
#undef PG8_BAR
#undef PG8_SCHED
}
}


constexpr int NWAVES = 8, NTHR = NWAVES * 64;
#ifndef MK_N_LAUNCHES
#define MK_N_LAUNCHES 1
#endif
constexpr int N_PHASES = 10;
#ifndef PROBE_PHASE
#define PROBE_PHASE -1
#endif
constexpr int N_LAUNCHES = MK_N_LAUNCHES;
constexpr int DM = 1024, M_CTX = pg8::M_CTX, L_CTX = 256, B_CTX = 16, M_LAT = 8192, L_LAT = 2048, B_LAT = 4, M = M_CTX + M_LAT;
constexpr int NHEAD = 8, NKV = 2, HD = 128, KVW = 256, HYW = 512, NIN = 3072 + 2048, KMIX = 1024 + 512, DFF = 2816, NUP = 2 * DFF;
constexpr int NMOD = 6 * DM, MOD_KS = 16;
constexpr float EPS = 1e-6f;
constexpr int OUT_Y = 0, OUT_NEWK = M * DM, OUT_NEWV = OUT_NEWK + M_CTX * KVW;

constexpr size_t MiB = 1u << 20;
constexpr size_t WS_CTL = 0, CTL_ZERO_BYTES = 1 * MiB;
constexpr size_t WS_W1 = 2 * MiB;
constexpr size_t WS_W2 = 12 * MiB;
constexpr size_t WS_W3 = 15 * MiB;
constexpr size_t WS_W4 = 17 * MiB;
constexpr size_t WS_W5 = 28 * MiB;
constexpr size_t WS_MODP = 34 * MiB;
constexpr size_t WS_MOD = 36 * MiB;
constexpr size_t WS_ROPE = 36 * MiB + 256 * 1024;
constexpr size_t WS_CK = 37 * MiB;
constexpr size_t WS_CV = 37 * MiB + 512 * 1024;
constexpr size_t WS_FSL = 38 * MiB;
constexpr size_t WS_FSC = 46 * MiB;
constexpr size_t WS_HL = 228 * MiB;
constexpr size_t WS_HC = 244 * MiB;
constexpr size_t WS_XN = 48 * MiB;
constexpr size_t WS_Q = 72 * MiB;
constexpr size_t WS_K = 96 * MiB;
constexpr size_t WS_V = 102 * MiB;
constexpr size_t WS_HY = 108 * MiB;
constexpr size_t WS_GT = 144 * MiB;
constexpr size_t WS_AH = 192 * MiB;
constexpr size_t WS_MG = 72 * MiB;
constexpr size_t WS_ACT = 72 * MiB;
constexpr size_t WS_F32 = 144 * MiB;
constexpr size_t WS_END = 252 * MiB;
static_assert(WS_ACT + (size_t)M * DFF * 2 <= WS_GT && WS_F32 + (size_t)M * DM * 4 <= WS_AH && WS_MG + (size_t)M * DM * 2 <= WS_K && WS_HC + 2 * MiB <= WS_END && WS_FSC + MiB <= WS_XN, "d_ws map");
constexpr int CW_TMO = 0, CW_CODE = 1, CW_BAR = 4096;

constexpr int RING_OFF = 0, RING_BYTES = 131072;
constexpr int LDSCTL_OFF = RING_BYTES, MISC_OFF = LDSCTL_OFF + 320;
constexpr int LDS_BYTES = 147456;
static_assert(MISC_OFF + 128 <= LDS_BYTES, "LDS map");

#define GAS __attribute__((address_space(1)))
#define LAS __attribute__((address_space(3)))
typedef unsigned short bf16;
typedef unsigned v4u __attribute__((ext_vector_type(4)));
typedef unsigned v2u __attribute__((ext_vector_type(2)));
typedef float f32x4 __attribute__((ext_vector_type(4)));
typedef GAS unsigned gu32;
#define RLX_AGENT __ATOMIC_RELAXED, __HIP_MEMORY_SCOPE_AGENT
#define LDS_WAIT() asm volatile("s_waitcnt lgkmcnt(0)" ::: "memory")
#define VM_WAIT() asm volatile("s_waitcnt vmcnt(0)" ::: "memory")
__device__ __forceinline__ unsigned f2bf(float f) { unsigned u = __builtin_bit_cast(unsigned, f); return (u + 0x7fffu + ((u >> 16) & 1u)) >> 16; }
__device__ __forceinline__ unsigned pk2(float lo, float hi) { return f2bf(lo) | (f2bf(hi) << 16); }
__device__ __forceinline__ float bf2f(bf16 v) { return __uint_as_float((unsigned)v << 16); }
__device__ __forceinline__ float wave_sum(float v) {
#pragma unroll
    for (int o = 1; o < 64; o <<= 1) v += __shfl_xor(v, o);
    return v;
}
__device__ __forceinline__ float wave_max(float v) {
#pragma unroll
    for (int o = 1; o < 64; o <<= 1) v = fmaxf(v, __shfl_xor(v, o));
    return v;
}

#define XB_TMO      128
#define XB_XCNT(j)  (256  + 64 * (j))
#define XB_XSUB(j)  (1280 + 64 * (j))
#define XB_XGEN(j)  (2304 + 64 * (j))
#define XB_TOP      3328
#define XB_TOPGEN   3392
#define XCD_BAR_WORDS 3456
#define XB_SPIN_CAP (1u << 18)

__device__ __forceinline__ unsigned xb_ld(unsigned* p)              { return __hip_atomic_load(p, __ATOMIC_RELAXED, __HIP_MEMORY_SCOPE_AGENT); }
__device__ __forceinline__ unsigned xb_add(unsigned* p, unsigned v) { return __hip_atomic_fetch_add(p, v, __ATOMIC_RELAXED, __HIP_MEMORY_SCOPE_AGENT); }
__device__ __forceinline__ unsigned xb_xcc_id() { return (unsigned)__builtin_amdgcn_s_getreg((3 << 11) | 20) & 0xFu; }
#define XB_SPIN(cond, bar) do { unsigned _sp = 0; while (cond) { __builtin_amdgcn_s_sleep(1); \
    if ((++_sp & 255u) == 0u) { if (xb_ld(&(bar)[XB_TMO])) break; if (_sp > XB_SPIN_CAP) { atomicAdd(&(bar)[XB_TMO], 1u); break; } } } } while (0)

struct XcdBarrier {
    unsigned* bar; unsigned x;
    volatile LAS unsigned* st;
};

__device__ __forceinline__ XcdBarrier xcd_barrier_post(unsigned* bar, volatile LAS unsigned* st, int wave) {
    XcdBarrier b; b.bar = bar; b.x = xb_xcc_id(); b.st = st;
    if (wave == 0 && lane_id() == 0) (void)xb_add(&bar[XB_XCNT(b.x)], 1u);
    return b;
}
__device__ __forceinline__ void xcd_barrier_complete(unsigned* bar, unsigned x, unsigned& nloc, unsigned& nx) {
    const unsigned G = gridDim.x * gridDim.y * gridDim.z;
    unsigned sum, cnt, mine, sp = 0u;
    for (;;) {
        sum = 0u; cnt = 0u; mine = 0u;
#pragma unroll
        for (unsigned j = 0; j < 16; ++j) { const unsigned c = xb_ld(&bar[XB_XCNT(j)]); sum += c; cnt += (c > 0u) ? 1u : 0u; mine = (j == x) ? c : mine; }
        if (sum == G) break;
        __builtin_amdgcn_s_sleep(1);
        if ((++sp & 255u) == 0u) { if (xb_ld(&bar[XB_TMO])) break; if (sp > XB_SPIN_CAP) { atomicAdd(&bar[XB_TMO], 1u); break; } }
    }
    nloc = mine > 0u ? mine : 1u; nx = cnt > 0u ? cnt : 1u;
}

__device__ __forceinline__ void xcd_barrier(const XcdBarrier& b, int wave) {
    asm volatile("s_waitcnt vmcnt(0)" ::: "memory");
    __syncthreads();
    if (wave == 0 && lane_id() == 0) {
        unsigned* bar = b.bar;
        __builtin_amdgcn_s_waitcnt(0);
        unsigned nloc = b.st[0], nx = b.st[1];
        if (nloc == 0u) { xcd_barrier_complete(bar, b.x, nloc, nx); b.st[0] = nloc; b.st[1] = nx; }
        const unsigned old = xb_add(&bar[XB_XSUB(b.x)], 1u);
        const unsigned gen = old / nloc;
        if (old + 1u == (gen + 1u) * nloc) {
            __builtin_amdgcn_fence(__ATOMIC_RELEASE, "agent");
            asm volatile("s_waitcnt vmcnt(0)" ::: "memory");
            const unsigned og = xb_add(&bar[XB_TOP], 1u);
            const unsigned tg = og / nx;
            if (og + 1u == (tg + 1u) * nx) xb_add(&bar[XB_TOPGEN], 1u);
            else XB_SPIN(xb_ld(&bar[XB_TOPGEN]) == tg, bar);
            __builtin_amdgcn_fence(__ATOMIC_ACQUIRE, "agent");
            xb_add(&bar[XB_XGEN(b.x)], 1u);
            asm volatile("s_waitcnt vmcnt(0)" ::: "memory");
        } else {
            XB_SPIN(xb_ld(&bar[XB_XGEN(b.x)]) == gen, bar);
            __builtin_amdgcn_fence(__ATOMIC_ACQUIRE, "agent");
            asm volatile("s_waitcnt vmcnt(0)" ::: "memory");
        }
    }
    __syncthreads();
}

struct Args { const float* in[33]; float* out; unsigned char* ws; int ph_lo, ph_hi, li, pad; };
struct Frame {
    LAS unsigned char* lds;
    volatile LAS unsigned* MISC;
    gu32* ctl;
    int wave;
    int vcu, G;
    float* out; unsigned char* ws;
};
typedef const float* const __attribute__((address_space(4))) * kargp_t;
__device__ __forceinline__ const float* inp(int i) { return ((kargp_t)__builtin_amdgcn_kernarg_segment_ptr())[i]; }
enum { I_XP = 0, I_XS, I_C, I_CK, I_CV, I_CCTX, I_NMPRE, I_NMPOST, I_NFPRE, I_NFPOST, I_WMOD, I_BMOD, I_WIN, I_SINK, I_CONVW, I_CONVB,
       I_FW1, I_FB1, I_FFR1, I_FW2, I_FB2, I_FFR2, I_FW3, I_FB3, I_FDEC, I_SKIP, I_WPA, I_WPH, I_WGATE, I_BGATE, I_WO, I_WUP, I_WDOWN };

__device__ __forceinline__ const float* xrow_ptr(const Args& A, int m) { return m < M_CTX ? inp(I_XP) + (size_t)m * DM : inp(I_XS) + (size_t)(m - M_CTX) * DM; }
__device__ __forceinline__ int mod_row(int m) { return m < M_CTX ? 0 : 1 + ((m - M_CTX) >> 11); }

template <class Map>
__device__ __forceinline__ void p0_transpose_item(const float* W, int K, int N, bf16* WT, int ldk, int koff, Map map, LAS float* scr, int item, int lane) {
    const int nblk = N / 32, kb = item / nblk, nb = item % nblk, k0 = 64 * kb, n0 = 32 * nb;
    float tv[32];
#pragma unroll
    for (int i = 0; i < 32; ++i) tv[i] = W[(size_t)(k0 + 2 * i + (lane >> 5)) * N + n0 + (lane & 31)];
#pragma unroll
    for (int i = 0; i < 32; ++i) scr[(2 * i + (lane >> 5)) * 33 + (lane & 31)] = tv[i];
    LDS_WAIT(); asm volatile("" ::: "memory");
    const int c = lane & 7;
#pragma unroll
    for (int j = 0; j < 4; ++j) { const int n = (lane >> 3) + 8 * j; const LAS float* s = scr + (8 * c) * 33 + n;
        v4u o; o.x = pk2(s[0 * 33], s[1 * 33]); o.y = pk2(s[2 * 33], s[3 * 33]); o.z = pk2(s[4 * 33], s[5 * 33]); o.w = pk2(s[6 * 33], s[7 * 33]);
        *(GAS v4u*)(WT + (size_t)map(n0 + n) * ldk + koff + k0 + 8 * c) = o; }
    LDS_WAIT(); asm volatile("" ::: "memory");
}
struct MapIn {
    __device__ __forceinline__ int operator()(int n) const {
        if (n >= 1536) return n + 2048;
        if (n >= 1280) return n;
        const int d = n & 127, half = d >> 6, r = d & 63, nn = r >> 5, q = r & 31, idx8 = q >> 2, j = q & 3, wc = half * 2 + (idx8 >> 2), fq = idx8 & 3;
        return (n & ~127) + 32 * wc + 8 * fq + 4 * nn + j; }
};
struct MapOff { int off; __device__ __forceinline__ int operator()(int n) const { return n + off; } };
struct MapUp {
    __device__ __forceinline__ int operator()(int n) const { const int up = n >= DFF ? 1 : 0, i = n - up * DFF; return (i >> 7) * 256 + up * 128 + (i & 127); }
};

__device__ __forceinline__ float silu_f(float x) { return x / (1.0f + __expf(-x)); }

__device__ __forceinline__ void p0_filter_item(int item, int L, float* FS, LAS float* scr, int lane) {
    const int tb = item >> 2, cb = item & 3, bwd = cb >> 1, tfirst = tb * 16 + bwd, col = cb * 256 + lane * 4;
    LAS float* feat = scr;
    LAS float* h1T = scr + 320;
    LAS float* h2T = scr + 320 + 1024;
    const float invL = 1.0f / (float)L;
    {
        const int k = lane >> 2, b0 = (lane & 3) * 2; const float tt = (float)(tfirst + k);
        const float base = (6.283185307179586f * tt) * invL;
#pragma unroll
        for (int q = 0; q < 2; ++q) { const float band = 1e-4f + (float)(b0 + q) * ((7.0f - 1e-4f) / 7.0f); const float ang = base * band;
            feat[k * 20 + 1 + b0 + q] = cosf(ang); feat[k * 20 + 9 + b0 + q] = sinf(ang); }
        if ((lane & 3) == 0) feat[k * 20] = tt * invL;
    }
    LDS_WAIT(); asm volatile("" ::: "memory");
    {
        float w1c[17];
#pragma unroll
        for (int f = 0; f < 17; ++f) w1c[f] = inp(I_FW1)[f * 64 + lane];
        const float b1 = inp(I_FB1)[lane], fr1 = inp(I_FFR1)[lane];
#pragma unroll 4
        for (int k = 0; k < 16; ++k) { float s = b1;
#pragma unroll
            for (int f = 0; f < 17; ++f) s += feat[k * 20 + f] * w1c[f];
            h1T[lane * 16 + k] = sinf(fr1 * s); }
    }
    LDS_WAIT(); asm volatile("" ::: "memory");
    {
        float s2[16]; const float b2 = inp(I_FB2)[lane], fr2 = inp(I_FFR2)[lane];
#pragma unroll
        for (int k = 0; k < 16; ++k) s2[k] = b2;
#pragma unroll 1
        for (int j0 = 0; j0 < 64; j0 += 32) {
            float w2c[32];
#pragma unroll
            for (int u = 0; u < 32; ++u) w2c[u] = inp(I_FW2)[(j0 + u) * 64 + lane];
#pragma unroll
            for (int u = 0; u < 32; ++u) { const float w = w2c[u];
#pragma unroll
                for (int g = 0; g < 4; ++g) { const f32x4 h = *(const LAS f32x4*)(h1T + (j0 + u) * 16 + 4 * g); s2[4 * g] += h.x * w; s2[4 * g + 1] += h.y * w; s2[4 * g + 2] += h.z * w; s2[4 * g + 3] += h.w * w; } }
        }
#pragma unroll
        for (int k = 0; k < 16; ++k) h2T[lane * 16 + k] = sinf(fr2 * s2[k]);
    }
    LDS_WAIT(); asm volatile("" ::: "memory");
    f32x4 acc[16];
    { const f32x4 b3 = *(const f32x4*)(inp(I_FB3) + col);
#pragma unroll
      for (int k = 0; k < 16; ++k) acc[k] = b3; }
#pragma unroll 1
    for (int j0 = 0; j0 < 64; j0 += 16) {
        f32x4 w3c[16];
#pragma unroll
        for (int u = 0; u < 16; ++u) w3c[u] = *(const f32x4*)(inp(I_FW3) + (size_t)(j0 + u) * 1024 + col);
#pragma unroll
        for (int u = 0; u < 16; ++u) { const f32x4 w = w3c[u];
#pragma unroll
            for (int g = 0; g < 4; ++g) { const f32x4 h = *(const LAS f32x4*)(h2T + (j0 + u) * 16 + 4 * g);
                acc[4 * g] += h.x * w; acc[4 * g + 1] += h.y * w; acc[4 * g + 2] += h.z * w; acc[4 * g + 3] += h.w * w; } }
    }
    const f32x4 dec = *(const f32x4*)(inp(I_FDEC) + col);
#pragma unroll
    for (int k = 0; k < 16; ++k) { const float tn = (float)(tfirst + k) * invL; const bool dead = (tfirst + k) >= L;
#pragma unroll
        for (int q = 0; q < 4; ++q) acc[k][q] = dead ? 0.f : acc[k][q] * __expf(-tn * fabsf(dec[q])); }
    const int N2 = 2 * L;
    if (!bwd) {
#pragma unroll
        for (int q = 0; q < 4; ++q) { float* p = FS + (size_t)(col + q) * N2 + tfirst;
#pragma unroll
            for (int g = 0; g < 4; ++g) *(f32x4*)(p + 4 * g) = (f32x4){acc[4 * g][q], acc[4 * g + 1][q], acc[4 * g + 2][q], acc[4 * g + 3][q]}; }
    } else {
#pragma unroll
        for (int q = 0; q < 4; ++q) { float* p = FS + (size_t)(col - 512 + q) * N2 + (N2 - tfirst - 15);
#pragma unroll
            for (int g = 0; g < 4; ++g) *(f32x4*)(p + 4 * g) = (f32x4){acc[15 - 4 * g][q], acc[14 - 4 * g][q], acc[13 - 4 * g][q], acc[12 - 4 * g][q]}; }
    }
    LDS_WAIT(); asm volatile("" ::: "memory");
}

__device__ __forceinline__ void p0_prologue(Frame& F, const Args& A) {
    LAS float* scr = (LAS float*)(F.lds + RING_OFF + F.wave * 16384);
    const int gw = F.vcu * NWAVES + F.wave, NGW = F.G * NWAVES;
    bf16* W1 = (bf16*)(F.ws + WS_W1); bf16* W2 = (bf16*)(F.ws + WS_W2); bf16* W3 = (bf16*)(F.ws + WS_W3); bf16* W4 = (bf16*)(F.ws + WS_W4); bf16* W5 = (bf16*)(F.ws + WS_W5);
    constexpr int N_FILT_L = (L_LAT / 16) * 4, N_FILT = N_FILT_L + (L_CTX / 16) * 4;
    constexpr int T_IN = (DM / 64) * (3072 / 32), T_GATE = (DM / 64) * (2048 / 32), T_PA = (DM / 64) * (DM / 32), T_PH = (HYW / 64) * (DM / 32), T_O = T_PA,
                  T_UP = (DM / 64) * (NUP / 32), T_DOWN = (DFF / 64) * (DM / 32);
    constexpr int N_MODI = (NMOD / 256) * MOD_KS, N_ROPE = 32, N_CACHE = 2 * (B_LAT * 256 * KVW) / 512;
    constexpr int NITEMS = N_FILT + N_MODI + T_IN + T_GATE + N_ROPE + N_CACHE;
    for (int it = gw; it < NITEMS; it += NGW) {
        const int lane = lane_id();
        int r = it;
        if (r < N_FILT) { if (r < N_FILT_L) p0_filter_item(r, L_LAT, (float*)(F.ws + WS_FSL), scr, lane); else p0_filter_item(r - N_FILT_L, L_CTX, (float*)(F.ws + WS_FSC), scr, lane); continue; } r -= N_FILT;
        if (r < N_MODI) {
            const int cg = r / MOD_KS, ks = r % MOD_KS, col = cg * 256 + lane * 4;
            f32x4 acc[5];
#pragma unroll
            for (int q = 0; q < 5; ++q) acc[q] = (f32x4){0.f, 0.f, 0.f, 0.f};
#pragma unroll 1
            for (int k0 = ks * 64; k0 < ks * 64 + 64; k0 += 16) {
                f32x4 w[16];
#pragma unroll
                for (int u = 0; u < 16; ++u) w[u] = *(const f32x4*)(inp(I_WMOD) + (size_t)(k0 + u) * NMOD + col);
#pragma unroll
                for (int u = 0; u < 16; ++u) { const int k = k0 + u;
                    acc[0] += silu_f(inp(I_CCTX)[k]) * w[u];
#pragma unroll
                    for (int q = 1; q < 5; ++q) acc[q] += silu_f(inp(I_C)[(q - 1) * DM + k]) * w[u]; }
            }
            float* mp = (float*)(F.ws + WS_MODP) + (size_t)ks * 5 * NMOD + col;
#pragma unroll
            for (int q = 0; q < 5; ++q) *(f32x4*)(mp + q * NMOD) = acc[q];
            continue; } r -= N_MODI;
        if (r < T_IN) { p0_transpose_item(inp(I_WIN), DM, 3072, W1, DM, 0, MapIn{}, scr, r, lane); continue; } r -= T_IN;
        if (r < T_GATE) { p0_transpose_item(inp(I_WGATE), DM, 2048, W1, DM, 0, MapOff{1536}, scr, r, lane); continue; } r -= T_GATE;
        if (r < N_ROPE) {
            const int pos = 2 * r + (lane >> 5), f = lane & 31;
            const float inv = expf(-(float)f * (9.210340371976184f / 32.0f));
            const float ang = (float)pos * inv;
            float* rp = (float*)(F.ws + WS_ROPE) + (size_t)(pos * 32 + f) * 2; rp[0] = cosf(ang); rp[1] = sinf(ang);
            continue; } r -= N_ROPE;
        {
            const int half = (B_LAT * 256 * KVW) / 512; const bool isv = r >= half; const int idx = (isv ? r - half : r) * 512 + lane * 8;
            const float* src = (isv ? inp(I_CV) : inp(I_CK)) + idx; bf16* dst = (bf16*)(F.ws + (isv ? WS_CV : WS_CK)) + idx;
            const f32x4 a = *(const f32x4*)src, b = *(const f32x4*)(src + 4);
            v4u o; o.x = pk2(a.x, a.y); o.y = pk2(a.z, a.w); o.z = pk2(b.x, b.y); o.w = pk2(b.z, b.w); *(v4u*)dst = o;
        }
    }
}


__device__ __forceinline__ void deferred_transposes(Frame& F, int which, int gw, int NGW) {
    LAS float* scr = (LAS float*)(F.lds + RING_OFF + F.wave * 16384);
    bf16* W2 = (bf16*)(F.ws + WS_W2); bf16* W3 = (bf16*)(F.ws + WS_W3); bf16* W4 = (bf16*)(F.ws + WS_W4); bf16* W5 = (bf16*)(F.ws + WS_W5);
    constexpr int T_PA = (DM / 64) * (DM / 32), T_PH = (HYW / 64) * (DM / 32), T_O = T_PA, T_UP = (DM / 64) * (NUP / 32), T_DOWN = (DFF / 64) * (DM / 32);
    const int n = which == 1 ? T_PA + T_PH + T_O : (which == 2 ? T_UP : T_DOWN);
    for (int it = gw; it < n; it += NGW) {
        const int lane = lane_id(); int r = it;
        if (which == 1) {
            if (r < T_PA) { p0_transpose_item(inp(I_WPA), DM, DM, W2, KMIX, 0, MapOff{0}, scr, r, lane); continue; } r -= T_PA;
            if (r < T_PH) { p0_transpose_item(inp(I_WPH), HYW, DM, W2, KMIX, DM, MapOff{0}, scr, r, lane); continue; } r -= T_PH;
            p0_transpose_item(inp(I_WO), DM, DM, W3, DM, 0, MapOff{0}, scr, r, lane);
        } else if (which == 2) p0_transpose_item(inp(I_WUP), DM, NUP, W4, DM, 0, MapUp{}, scr, r, lane);
        else p0_transpose_item(inp(I_WDOWN), DFF, DM, W5, DFF, 0, MapOff{0}, scr, r, lane);
    }
}

__device__ __forceinline__ float mod_total(const Frame& F, const Args& A, int r, int col) {
    const float* mp = (const float*)(F.ws + WS_MODP) + (size_t)r * NMOD + col; float s = inp(I_BMOD)[col];
#pragma unroll
    for (int ks = 0; ks < MOD_KS; ++ks) s += mp[(size_t)ks * 5 * NMOD];
    return s;
}
__device__ __forceinline__ void p1_rows(Frame& F, const Args& A) {
    const int L_lane = lane_id(), L_tid = F.wave * 64 + L_lane;
    if (F.vcu < 30) {
        const int r = F.vcu / 6, c0 = (F.vcu % 6) * 1024;
        for (int i = L_tid; i < 1024; i += NTHR) ((float*)(F.ws + WS_MOD))[r * NMOD + c0 + i] = mod_total(F, A, r, c0 + i);
    }
    LAS float* vA = (LAS float*)(F.lds + RING_OFF); LAS float* vB = vA + DM;
    int cur = -1;
    bf16* XN = (bf16*)(F.ws + WS_XN);
    for (int ch = 0; ch < 3; ++ch) {
        const int row0 = F.vcu * 48 + ch * 16;
        if (row0 >= M) break;
        const int r = mod_row(row0);
        if (r != cur) {
            __syncthreads();
            for (int i = L_tid; i < DM; i += NTHR) { vA[i] = inp(I_NMPRE)[i] * (1.0f + mod_total(F, A, r, DM + i)); vB[i] = mod_total(F, A, r, i); }
            __syncthreads(); cur = r;
        }
#pragma unroll 1
        for (int q = 0; q < 2; ++q) {
            const int m = row0 + F.wave * 2 + q;
            const f32x4* xr = (const f32x4*)xrow_ptr(A, m) + L_lane;
            f32x4 v[4]; float s = 0.f;
#pragma unroll
            for (int j = 0; j < 4; ++j) { v[j] = xr[64 * j]; s += (v[j].x * v[j].x + v[j].y * v[j].y) + (v[j].z * v[j].z + v[j].w * v[j].w); }
            const float rstd = 1.0f / sqrtf(wave_sum(s) * (1.0f / DM) + EPS);
            unsigned long long* o8 = (unsigned long long*)(XN + (size_t)m * DM) + L_lane;
#pragma unroll
            for (int j = 0; j < 4; ++j) { const int c = 4 * L_lane + 256 * j;
                const float a = v[j].x * rstd * vA[c] + vB[c], b = v[j].y * rstd * vA[c + 1] + vB[c + 1], cc = v[j].z * rstd * vA[c + 2] + vB[c + 2], d = v[j].w * rstd * vA[c + 3] + vB[c + 3];
                o8[64 * j] = (unsigned long long)pk2(a, b) | ((unsigned long long)pk2(cc, d) << 32); }
        }
    }
}


namespace att {
using bf16x8 = __attribute__((ext_vector_type(8))) short;
using s16x4  = __attribute__((ext_vector_type(4))) short;
using f32x16 = __attribute__((ext_vector_type(16))) float;
using u32x4  = __attribute__((ext_vector_type(4))) unsigned;
constexpr int D = 128, NW = 8, QBLK = 32, KVBLK = 64, LDKV = 256;
constexpr int SHM_V = KVBLK * D * 2, SHM_K = KVBLK * D * 2, SHM_ATTN = 2 * SHM_V + 2 * SHM_K + NW * 64 * 4;
constexpr float THR2 = 8.0f;
#define KSWZ(row, colB) ((row) * 256 + ((colB) ^ (((row) & 7) << 4)))
#define SBAR() __builtin_amdgcn_sched_barrier(0)
__device__ __forceinline__ int crow(int r, int hi) { return (r & 3) + 8 * (r >> 2) + 4 * hi; }
__device__ __forceinline__ unsigned cvtpk(float lo, float hi) { unsigned r; asm volatile("v_cvt_pk_bf16_f32 %0, %1, %2" : "=v"(r) : "v"(lo), "v"(hi)); return r; }
__device__ __forceinline__ void partialSM(f32x16& p0, f32x16& p1, float& m_reg, float& mn, float& alpha) {
  float pmax = p0[0];
#pragma unroll
  for (int r = 1; r < 16; ++r) pmax = fmaxf(pmax, p0[r]);
#pragma unroll
  for (int r = 0; r < 16; ++r) pmax = fmaxf(pmax, p1[r]);
  { auto rr = __builtin_amdgcn_permlane32_swap(__float_as_uint(pmax), __float_as_uint(pmax), false, false);
    pmax = fmaxf(__uint_as_float(rr[0]), __uint_as_float(rr[1])); }
  if (__builtin_expect(__all(pmax - m_reg <= THR2), 1)) { mn = m_reg; alpha = 1.f; }
  else { mn = fmaxf(m_reg, pmax); alpha = __builtin_amdgcn_exp2f(m_reg - mn); m_reg = mn; }
#pragma unroll
  for (int r = 0; r < 16; ++r) p0[r] = p0[r] - mn;
#pragma unroll
  for (int r = 0; r < 16; ++r) p1[r] = p1[r] - mn;
#pragma unroll
  for (int r = 0; r < 16; ++r) p0[r] = __builtin_amdgcn_exp2f(p0[r]);
}
__device__ __forceinline__ void finishSM(f32x16& p0, f32x16& p1, float alpha, float& l_reg, bf16x8& pa0, bf16x8& pa1, bf16x8& pa2, bf16x8& pa3) {
#pragma unroll
  for (int r = 0; r < 16; ++r) p1[r] = __builtin_amdgcn_exp2f(p1[r]);
  float ps = 0;
#pragma unroll
  for (int r = 0; r < 16; ++r) ps += p0[r];
#pragma unroll
  for (int r = 0; r < 16; ++r) ps += p1[r];
  { auto rr = __builtin_amdgcn_permlane32_swap(__float_as_uint(ps), __float_as_uint(ps), false, false);
    ps = __uint_as_float(rr[0]) + __uint_as_float(rr[1]); }
  l_reg = l_reg * alpha + ps;
#define PK4(P, BASE, OUT) do { unsigned a0 = cvtpk(P[BASE + 0], P[BASE + 1]), a1 = cvtpk(P[BASE + 2], P[BASE + 3]);   \
    unsigned b0 = cvtpk(P[BASE + 4], P[BASE + 5]), b1 = cvtpk(P[BASE + 6], P[BASE + 7]);                              \
    auto r0 = __builtin_amdgcn_permlane32_swap(a0, b0, false, false); auto r1 = __builtin_amdgcn_permlane32_swap(a1, b1, false, false); \
    u32x4 w = {r0[0], r1[0], r0[1], r1[1]}; OUT = *reinterpret_cast<bf16x8*>(&w); } while (0)
  PK4(p0, 0, pa0); PK4(p0, 8, pa1); PK4(p1, 0, pa2); PK4(p1, 8, pa3);
#undef PK4
}
__device__ __forceinline__ void qkt(f32x16& p0, f32x16& p1, const LAS char* Ks, const bf16x8* qr, int r32, int hi) {
  p0 = f32x16{}; p1 = f32x16{};
#pragma unroll
  for (int d0 = 0; d0 < 8; ++d0) { int cb = (d0 * 16 + hi * 8) * 2;
    bf16x8 b0 = *reinterpret_cast<const LAS bf16x8*>(Ks + KSWZ(r32, cb));
    bf16x8 b1 = *reinterpret_cast<const LAS bf16x8*>(Ks + KSWZ(32 + r32, cb));
    p0 = __builtin_amdgcn_mfma_f32_32x32x16_bf16(b0, qr[d0], p0, 0, 0, 0);
    p1 = __builtin_amdgcn_mfma_f32_32x32x16_bf16(b1, qr[d0], p1, 0, 0, 0); }
}
__device__ __forceinline__ void wmask(f32x16& p0, f32x16& p1, int kd, int hi) {
  const int b = kd + 4 * hi;
#pragma unroll
  for (int r = 0; r < 16; ++r) { const int d = b + (r & 3) + 8 * (r >> 2);
    if (d > 128 || d < -128) p0[r] = -1e30f;
    if (d + 32 > 128 || d + 32 < -128) p1[r] = -1e30f; }
}
__device__ __forceinline__ int v_st(int k, int c) { const int kk = (k & ~0xC) | ((k & 4) << 1) | ((k & 8) >> 1); return ((kk >> 3) * 4 + (c >> 5)) * 512 + ((kk & 7) * 32 + (c & 31)) * 2; }
__device__ __forceinline__ int v_rd_base(int lane) { return ((lane & 3) << 3) | (((lane >> 2) & 3) << 6) | (((lane >> 4) & 1) << 5) | (((lane >> 5) & 1) << 8); }
constexpr int v_rd_off(int d0, int ks, int half) { return d0 * 512 + ks * 4096 + half * 2048; }
template <int OFF> __device__ __forceinline__ s16x4 tr_read(int vb) {
  s16x4 r; asm volatile("ds_read_b64_tr_b16 %0, %1 offset:%2" : "=&v"(r) : "v"(vb), "i"(OFF) : "memory"); return r;
}
template <int D0> __device__ __forceinline__ void pv_one(f32x16& od, int vb, bf16x8 pa0, bf16x8 pa1, bf16x8 pa2, bf16x8 pa3) {
  const s16x4 l0 = tr_read<v_rd_off(D0, 0, 0)>(vb), h0 = tr_read<v_rd_off(D0, 0, 1)>(vb), l1 = tr_read<v_rd_off(D0, 1, 0)>(vb), h1 = tr_read<v_rd_off(D0, 1, 1)>(vb);
  const s16x4 l2 = tr_read<v_rd_off(D0, 2, 0)>(vb), h2 = tr_read<v_rd_off(D0, 2, 1)>(vb), l3 = tr_read<v_rd_off(D0, 3, 0)>(vb), h3 = tr_read<v_rd_off(D0, 3, 1)>(vb);
  asm volatile("s_waitcnt lgkmcnt(0)" ::: "memory"); SBAR();
#define PK(L, H) (bf16x8){L[0], L[1], L[2], L[3], H[0], H[1], H[2], H[3]}
  od = __builtin_amdgcn_mfma_f32_32x32x16_bf16(pa0, PK(l0, h0), od, 0, 0, 0);
  od = __builtin_amdgcn_mfma_f32_32x32x16_bf16(pa1, PK(l1, h1), od, 0, 0, 0);
  od = __builtin_amdgcn_mfma_f32_32x32x16_bf16(pa2, PK(l2, h2), od, 0, 0, 0);
  od = __builtin_amdgcn_mfma_f32_32x32x16_bf16(pa3, PK(l3, h3), od, 0, 0, 0);
#undef PK
}
__device__ __forceinline__ void pv_d0(f32x16* o, int vb, bf16x8 pa0, bf16x8 pa1, bf16x8 pa2, bf16x8 pa3) {
  pv_one<0>(o[0], vb, pa0, pa1, pa2, pa3); pv_one<1>(o[1], vb, pa0, pa1, pa2, pa3); pv_one<2>(o[2], vb, pa0, pa1, pa2, pa3); pv_one<3>(o[3], vb, pa0, pa1, pa2, pa3);
}
__device__ __forceinline__ void attn_item(const bf16* Qw, const bf16* Kw, const bf16* Vw, const bf16* Kc, const bf16* Vc, int nwt, int NT, bool masked, int qrel,
                                          float sinkl, bf16* Ow, LAS char* lds, int wid, int lane) {
  const int tid = wid * 64 + lane, r32 = lane & 31, hi = lane >> 5;
  LAS char* V_lds = lds; LAS char* K_lds = lds + 2 * SHM_V;
  LAS float* ws = (LAS float*)(lds + 2 * SHM_V + 2 * SHM_K) + wid * 64; LAS float* li_l = ws; LAS float* al_l = ws + 32;
  float m_reg = sinkl, l_reg = 1.0f; f32x16 o[4] = {}; bf16x8 qr[8];
  const bf16* Qp = Qw + (long)r32 * 1024 + hi * 8;
#pragma unroll
  for (int d0 = 0; d0 < 8; ++d0) qr[d0] = *reinterpret_cast<const bf16x8*>(Qp + d0 * 16);
  const int sr = tid >> 4, sc = (tid & 15) * 8, vst0 = v_st(sr, sc), vst1 = v_st(32 + sr, sc);
  const int vb0 = (int)(uintptr_t)V_lds + v_rd_base(lane);
  const int qd = qrel + r32;
  struct { bf16x8 vs0, vs1, ks0, ks1; } sr_[2];
#define TK(t) (((t) < nwt) ? Kw + (long)(t) * KVBLK * LDKV : Kc + (long)((t) - nwt) * KVBLK * LDKV)
#define TV(t) (((t) < nwt) ? Vw + (long)(t) * KVBLK * LDKV : Vc + (long)((t) - nwt) * KVBLK * LDKV)
#define SLOAD(i, t) do { const bf16* kp_ = TK(t); const bf16* vp_ = TV(t); \
    sr_[i].vs0 = *reinterpret_cast<const bf16x8*>(vp_ + (long)sr * LDKV + sc); sr_[i].vs1 = *reinterpret_cast<const bf16x8*>(vp_ + (long)(32 + sr) * LDKV + sc); \
    sr_[i].ks0 = *reinterpret_cast<const bf16x8*>(kp_ + (long)sr * LDKV + sc); sr_[i].ks1 = *reinterpret_cast<const bf16x8*>(kp_ + (long)(32 + sr) * LDKV + sc); } while (0)
#define SWRITE(b, i) do { *(LAS bf16x8*)(V_lds + (b) * SHM_V + vst0) = sr_[i].vs0;          \
    *(LAS bf16x8*)(V_lds + (b) * SHM_V + vst1) = sr_[i].vs1; int kc = sc * 2;               \
    *(LAS bf16x8*)(K_lds + (b) * SHM_K + KSWZ(sr, kc)) = sr_[i].ks0;                       \
    *(LAS bf16x8*)(K_lds + (b) * SHM_K + KSWZ(32 + sr, kc)) = sr_[i].ks1; } while (0)
#define SWAIT() asm volatile("s_waitcnt vmcnt(4)" ::: "memory")
#define RESC(a) do { if (__any((a) < 1.f)) { if (hi == 0) al_l[r32] = (a); asm volatile("s_waitcnt lgkmcnt(0)" ::: "memory"); \
    _Pragma("unroll") for (int d = 0; d < 4; ++d) _Pragma("unroll") for (int r = 0; r < 16; ++r) o[d][r] *= al_l[crow(r, hi)]; } } while (0)
#define MASK(P0, P1, t) do { if (masked && (t) < nwt) wmask(P0, P1, (t) * KVBLK - qd, hi); } while (0)
  f32x16 pA0, pA1, pB0, pB1; float mnA, mnB, alA, alB; bf16x8 pa0, pa1, pa2, pa3;
  constexpr int SE = 0, SO = 1;
  SLOAD(SE, 0); asm volatile("s_waitcnt vmcnt(0)" ::: "memory"); SWRITE(0, SE); __syncthreads();
  qkt(pA0, pA1, K_lds, qr, r32, hi); MASK(pA0, pA1, 0); partialSM(pA0, pA1, m_reg, mnA, alA);
  SLOAD(SO, 1); if (2 < NT) SLOAD(SE, 2);
  SWAIT(); SWRITE(1, SO); __syncthreads();
  for (int j = 1; j + 1 < NT; j += 2) {
    SBAR(); qkt(pB0, pB1, K_lds + SHM_K, qr, r32, hi); MASK(pB0, pB1, j);
    finishSM(pA0, pA1, alA, l_reg, pa0, pa1, pa2, pa3); SBAR();
    SLOAD(SO, j + 2); SBAR();
    pv_d0(o, vb0, pa0, pa1, pa2, pa3); partialSM(pB0, pB1, m_reg, mnB, alB);
    __syncthreads(); SWAIT(); SWRITE(0, SE);
    RESC(alB); __syncthreads();
    SBAR(); qkt(pA0, pA1, K_lds, qr, r32, hi); MASK(pA0, pA1, j + 1);
    finishSM(pB0, pB1, alB, l_reg, pa0, pa1, pa2, pa3); SBAR();
    if (j + 3 < NT) SLOAD(SE, j + 3); SBAR();
    pv_d0(o, vb0 + SHM_V, pa0, pa1, pa2, pa3); partialSM(pA0, pA1, m_reg, mnA, alA);
    __syncthreads(); SWAIT(); SWRITE(1, SO);
    RESC(alA); __syncthreads();
  }
  SBAR(); qkt(pB0, pB1, K_lds + SHM_K, qr, r32, hi); MASK(pB0, pB1, NT - 1);
  finishSM(pA0, pA1, alA, l_reg, pa0, pa1, pa2, pa3); SBAR();
  pv_d0(o, vb0, pa0, pa1, pa2, pa3); partialSM(pB0, pB1, m_reg, mnB, alB);
  __syncthreads(); RESC(alB);
  finishSM(pB0, pB1, alB, l_reg, pa0, pa1, pa2, pa3); SBAR();
  pv_d0(o, vb0 + SHM_V, pa0, pa1, pa2, pa3);
  if (hi == 0) li_l[r32] = l_reg; asm volatile("s_waitcnt lgkmcnt(0)" ::: "memory");
  float rli[16];
#pragma unroll
  for (int r = 0; r < 16; ++r) rli[r] = __builtin_amdgcn_rcpf(li_l[crow(r, hi)]);
#pragma unroll
  for (int r = 0; r < 16; ++r) { const int orow = crow(r, hi);
#pragma unroll
    for (int d0 = 0; d0 < 4; ++d0) Ow[(long)orow * 1536 + d0 * 32 + r32] = (bf16)f2bf(o[d0][r] * rli[r]); }
  __syncthreads();
#undef TK
#undef TV
#undef SLOAD
#undef SWRITE
#undef SWAIT
#undef RESC
#undef MASK
}
#undef KSWZ
#undef SBAR
}

__device__ __forceinline__ void p3_attention(Frame& F) {
    const int wid = F.wave;
    const bf16* Qb = (const bf16*)(F.ws + WS_Q); const bf16* Kb = (const bf16*)(F.ws + WS_K); const bf16* Vb = (const bf16*)(F.ws + WS_V);
    const bf16* CK = (const bf16*)(F.ws + WS_CK); const bf16* CV = (const bf16*)(F.ws + WS_CV); bf16* AH = (bf16*)(F.ws + WS_AH);
    LAS char* lds = (LAS char*)(F.lds + RING_OFF);
    for (int it = F.vcu; it < 256 + 128; it += F.G) {
        const int lane = lane_id();
        int head, tok0, nwt, NT, qrel; bool masked; size_t krow, crow_; int kv;
        if (it < 256) {
            const int hp = it & 1, qb = (it >> 1) & 15, b = it >> 6; kv = (it >> 5) & 1;
            head = kv * 4 + hp * 2 + (wid >> 2);
            tok0 = M_CTX + b * L_LAT + qb * 128 + (wid & 3) * 32;
            const int kstart = qb == 0 ? 0 : (qb - 1) * 128, kend = qb == 15 ? L_LAT : (qb + 2) * 128; nwt = (kend - kstart) / 64; NT = nwt + 4;
            krow = (size_t)M_CTX + (size_t)b * L_LAT + kstart; crow_ = (size_t)b * 256; masked = true; qrel = qb * 128 + (wid & 3) * 32 - kstart;
        } else {
            const int ci = it - 256, b = ci >> 3; head = ci & 7; kv = head >> 2;
            tok0 = b * L_CTX + wid * 32; krow = (size_t)b * L_CTX; crow_ = 0; nwt = 4; NT = 4; masked = false; qrel = 0;
        }
        const float sinkl = inp(I_SINK)[head] * 1.4426950408889634f;
        att::attn_item(Qb + (size_t)tok0 * DM + head * HD, Kb + krow * KVW + kv * HD, Vb + krow * KVW + kv * HD,
                       CK + crow_ * KVW + kv * HD, CV + crow_ * KVW + kv * HD, nwt, NT, masked, qrel, sinkl, AH + (size_t)tok0 * KMIX + head * HD, lds, wid, lane);
    }
}


namespace hy {
typedef float f32x2 __attribute__((ext_vector_type(2)));
__device__ __forceinline__ f32x2 cmul(f32x2 a, f32x2 b) { return (f32x2){a.x * b.x - a.y * b.y, a.x * b.y + a.y * b.x}; }
template <bool INV> __device__ __forceinline__ f32x2 muli(f32x2 a) { return INV ? (f32x2){-a.y, a.x} : (f32x2){a.y, -a.x}; }
template <bool INV> __device__ __forceinline__ void dft8(f32x2 (&a)[8]) {
    const float r2 = 0.70710678118654752f;
    const f32x2 s0 = a[0] + a[4], d0 = a[0] - a[4], s1 = a[1] + a[5], d1 = a[1] - a[5], s2 = a[2] + a[6], d2 = a[2] - a[6], s3 = a[3] + a[7], d3 = a[3] - a[7];
    const f32x2 t0 = s0 + s2, t1 = s0 - s2, t2 = s1 + s3, t3 = muli<INV>(s1 - s3);
    a[0] = t0 + t2; a[4] = t0 - t2; a[2] = t1 + t3; a[6] = t1 - t3;
    const f32x2 e1 = INV ? (f32x2){(d1.x - d1.y) * r2, (d1.x + d1.y) * r2} : (f32x2){(d1.x + d1.y) * r2, (d1.y - d1.x) * r2};
    const f32x2 e3 = INV ? (f32x2){(-d3.x - d3.y) * r2, (d3.x - d3.y) * r2} : (f32x2){(d3.y - d3.x) * r2, (-d3.x - d3.y) * r2};
    const f32x2 e2 = muli<INV>(d2);
    const f32x2 u0 = d0 + e2, u1 = d0 - e2, u2 = e1 + e3, u3 = muli<INV>(e1 - e3);
    a[1] = u0 + u2; a[5] = u0 - u2; a[3] = u1 + u3; a[7] = u1 - u3;
}
template <bool INV> __device__ __forceinline__ void twiddle(f32x2 (&a)[8], float u) {
    const float c = __builtin_amdgcn_cosf(u), s = __builtin_amdgcn_sinf(u);
    const f32x2 w1 = (f32x2){c, INV ? s : -s};
    const f32x2 w2 = cmul(w1, w1), w3 = cmul(w2, w1), w4 = cmul(w2, w2), w5 = cmul(w4, w1), w6 = cmul(w3, w3), w7 = cmul(w4, w3);
    a[1] = cmul(a[1], w1); a[2] = cmul(a[2], w2); a[3] = cmul(a[3], w3); a[4] = cmul(a[4], w4); a[5] = cmul(a[5], w5); a[6] = cmul(a[6], w6); a[7] = cmul(a[7], w7);
}
__device__ __forceinline__ int layB(int e) { return e + (e >> 3); }
struct SyncWG { __device__ __forceinline__ void operator()() const { __syncthreads(); } };
struct SyncWave { __device__ __forceinline__ void operator()() const { asm volatile("s_waitcnt lgkmcnt(0)" ::: "memory"); } };
template <int NP, int MODE, class Sync>
__device__ __forceinline__ void fft_core(f32x2 (&a)[8], int i, LAS f32x2* C, LAS f32x2* B, f32x4* Hg, Sync sync) {
    constexpr int N = 1 << (3 * NP), Q0 = N / 8;
    dft8<false>(a); twiddle<false>(a, (float)i * (1.0f / N));
#pragma unroll
    for (int r = 0; r < 8; ++r) C[layB(i + Q0 * r)] = a[r];
    sync();
    if constexpr (NP == 4) {
        const int j = i & 63, e0 = (i >> 6) * 512 + j;
#pragma unroll
        for (int m = 0; m < 8; ++m) a[m] = C[layB(e0 + 64 * m)];
        dft8<false>(a); twiddle<false>(a, (float)j * (1.0f / 512));
#pragma unroll
        for (int r = 0; r < 8; ++r) C[layB(e0 + 64 * r)] = a[r];
        sync();
    }
    {
        const int j = i & 7, e0 = (i >> 3) * 64 + j;
#pragma unroll
        for (int m = 0; m < 8; ++m) a[m] = C[layB(e0 + 8 * m)];
        dft8<false>(a); twiddle<false>(a, (float)j * (1.0f / 64));
#pragma unroll
        for (int r = 0; r < 8; ++r) B[layB(e0 + 8 * r)] = a[r];
        sync();
    }
#pragma unroll
    for (int m = 0; m < 8; ++m) a[m] = B[9 * i + m];
    dft8<false>(a);
    if constexpr (MODE == 1) {
        const float sc = 1.0f / N;
#pragma unroll
        for (int mm = 0; mm < 4; ++mm) Hg[mm * Q0] = (f32x4){a[2 * mm].x * sc, a[2 * mm].y * sc, a[2 * mm + 1].x * sc, a[2 * mm + 1].y * sc};
    } else {
#pragma unroll
        for (int mm = 0; mm < 4; ++mm) { const f32x4 h = Hg[mm * Q0]; a[2 * mm] = cmul(a[2 * mm], (f32x2){h.x, h.y}); a[2 * mm + 1] = cmul(a[2 * mm + 1], (f32x2){h.z, h.w}); }
        dft8<true>(a);
#pragma unroll
        for (int m = 0; m < 8; ++m) B[9 * i + m] = a[m];
        sync();
        {
            const int j = i & 7, e0 = (i >> 3) * 64 + j;
#pragma unroll
            for (int r = 0; r < 8; ++r) a[r] = B[layB(e0 + 8 * r)];
            twiddle<true>(a, (float)j * (1.0f / 64)); dft8<true>(a);
#pragma unroll
            for (int m = 0; m < 8; ++m) C[layB(e0 + 8 * m)] = a[m];
            sync();
        }
        if constexpr (NP == 4) {
            const int j = i & 63, e0 = (i >> 6) * 512 + j;
#pragma unroll
            for (int r = 0; r < 8; ++r) a[r] = C[layB(e0 + 64 * r)];
            twiddle<true>(a, (float)j * (1.0f / 512)); dft8<true>(a);
#pragma unroll
            for (int m = 0; m < 8; ++m) C[layB(e0 + 64 * m)] = a[m];
            sync();
        }
#pragma unroll
        for (int r = 0; r < 8; ++r) a[r] = C[layB(i + Q0 * r)];
        twiddle<true>(a, (float)i * (1.0f / N)); dft8<true>(a);
    }
}
constexpr int BUF_SLOTS_L = 4096 + 512, BUF_SLOTS_C = 512 + 64;

__device__ __forceinline__ float hval(const bf16* HY, size_t base, int t, int L, int col) {
    const int tc = t < 0 ? 0 : (t >= L ? L - 1 : t); const float v = bf2f(HY[(size_t)col * M + base + tc]); return (t >= 0 && t < L) ? v : 0.f; }
struct ConvW { float w0, w1, w2, b; };
__device__ __forceinline__ ConvW convw(int col) { const float* cw = inp(I_CONVW); ConvW w; w.w0 = cw[col]; w.w1 = cw[1536 + col]; w.w2 = cw[3072 + col]; w.b = inp(I_CONVB)[col]; return w; }
__device__ __forceinline__ float sconv(const bf16* HY, size_t base, int t, int L, int col, const ConvW& w) {
    return w.w0 * hval(HY, base, t - 1, L, col) + w.w1 * hval(HY, base, t, L, col) + w.w2 * hval(HY, base, t + 1, L, col) + w.b;
}
template <int NP, class Sync>
__device__ __forceinline__ void conv_item(const unsigned char* ws, int c, size_t base0, size_t base1, int i, LAS f32x2* C, LAS f32x2* B, f32x4* Hg, Sync sync, LAS bf16* st0, LAS bf16* st1) {
    constexpr int N = 1 << (3 * NP), L = N / 2, Q0 = N / 8;
    const bf16* HY = (const bf16*)(ws + WS_HY);
    const ConvW w1 = convw(512 + c), wv = convw(1024 + c);
    f32x2 a[8]; f32x2 z[4];
#pragma unroll
    for (int m = 0; m < 4; ++m) { const int t = i + Q0 * m;
        z[m].x = sconv(HY, base0, t, L, 512 + c, w1) * sconv(HY, base0, t, L, 1024 + c, wv);
        z[m].y = sconv(HY, base1, t, L, 512 + c, w1) * sconv(HY, base1, t, L, 1024 + c, wv);
        a[m] = z[m]; a[4 + m] = (f32x2){0.f, 0.f}; }
    fft_core<NP, 0, Sync>(a, i, C, B, Hg, sync);
    const ConvW w0 = convw(c); const float skip = inp(I_SKIP)[c];
#pragma unroll
    for (int m = 0; m < 4; ++m) { const int t = i + Q0 * m;
        const float y0 = a[m].x + z[m].x * skip, y1 = a[m].y + z[m].y * skip;
        st0[t * 4] = (bf16)f2bf(sconv(HY, base0, t, L, c, w0) * y0);
        st1[t * 4] = (bf16)f2bf(sconv(HY, base1, t, L, c, w0) * y1); }
}
template <int NP, class Sync>
__device__ __forceinline__ void spec_item(const float* FSc, int i, LAS f32x2* C, LAS f32x2* B, f32x4* Hg, Sync sync) {
    constexpr int N = 1 << (3 * NP), Q0 = N / 8;
    f32x2 a[8];
#pragma unroll
    for (int m = 0; m < 8; ++m) a[m] = (f32x2){FSc[i + Q0 * m], 0.f};
    fft_core<NP, 1, Sync>(a, i, C, B, Hg, sync);
}
}

__device__ __forceinline__ void p1_spectra(Frame& F) {
    const int lane = lane_id(), wid = F.wave;
    LAS hy::f32x2* Cl = (LAS hy::f32x2*)(F.lds + RING_OFF); LAS hy::f32x2* Bl = Cl;
    for (int c = F.vcu; c < HYW; c += F.G) {
        hy::spec_item<4>((const float*)(F.ws + WS_FSL) + (size_t)c * 4096, wid * 64 + lane, Cl, Bl, (f32x4*)(F.ws + WS_HL) + (size_t)c * 2048 + wid * 64 + lane, hy::SyncWG{});
        __syncthreads();
    }
    LAS hy::f32x2* Cw = (LAS hy::f32x2*)(F.lds + RING_OFF) + wid * hy::BUF_SLOTS_C; LAS hy::f32x2* Bw = Cw;
    for (int g = F.vcu; g < HYW / 8; g += F.G) {
        const int c = g * 8 + wid;
        hy::spec_item<3>((const float*)(F.ws + WS_FSC) + (size_t)c * 512, lane, Cw, Bw, (f32x4*)(F.ws + WS_HC) + (size_t)c * 256 + lane, hy::SyncWave{});
    }
    __syncthreads();
}
__device__ __forceinline__ void hyena_flush(unsigned char* ws, LAS bf16* stage, size_t row0, int c0, int tid) {
    bf16* AH = (bf16*)(ws + WS_AH) + 1024 + c0;
#pragma unroll
    for (int k = 0; k < 8; ++k) { const int r = tid + 512 * k; *(v2u*)(AH + (row0 + r) * KMIX) = *(const LAS v2u*)(stage + r * 4); }
}
constexpr int HY_STAGE_OFF = 40960;
__device__ __forceinline__ void p3_hyena(Frame& F) {
    const int wid = F.wave;
    LAS hy::f32x2* Cl = (LAS hy::f32x2*)(F.lds + RING_OFF);
    LAS bf16* stage = (LAS bf16*)(F.lds + RING_OFF + HY_STAGE_OFF);
    for (int it = F.vcu; it < 256; it += F.G) {
        const int g = it >> 1, pair = it & 1;
        const size_t base0 = (size_t)M_CTX + (size_t)(2 * pair) * L_LAT;
#pragma unroll 1
        for (int ci = 0; ci < 4; ++ci) {
            const int lane = lane_id(), c = g * 4 + ci;
            hy::conv_item<4>(F.ws, c, base0, base0 + L_LAT, wid * 64 + lane, Cl, Cl, (f32x4*)(F.ws + WS_HL) + (size_t)c * 2048 + wid * 64 + lane, hy::SyncWG{}, stage + ci, stage + L_LAT * 4 + ci);
            __syncthreads();
        }
        hyena_flush(F.ws, stage, base0, g * 4, wid * 64 + lane_id());
        __syncthreads();
    }
    LAS hy::f32x2* Cw = (LAS hy::f32x2*)(F.lds + RING_OFF) + wid * hy::BUF_SLOTS_C;
    for (int it = F.vcu - 128; it >= 0 && it < 128; it += F.G) {
#pragma unroll 1
        for (int ci = 0; ci < 4; ++ci) {
            const int lane = lane_id(), c = it * 4 + ci;
            const size_t base0 = (size_t)(2 * wid) * L_CTX;
            hy::conv_item<3>(F.ws, c, base0, base0 + L_CTX, lane, Cw, Cw, (f32x4*)(F.ws + WS_HC) + (size_t)c * 256 + lane, hy::SyncWave{}, stage + (2 * wid) * L_CTX * 4 + ci, stage + (2 * wid + 1) * L_CTX * 4 + ci);
        }
        __syncthreads();
        hyena_flush(F.ws, stage, 0, it * 4, wid * 64 + lane_id());
        __syncthreads();
    }
}

__device__ __forceinline__ void p6_rows(Frame& F, const Args& A) {
    const int L_lane = lane_id();
    const int gw = F.vcu * NWAVES + F.wave, NGW = F.G * NWAVES;
    const float* MIX = (const float*)(F.ws + WS_F32); const float* MOD = (const float*)(F.ws + WS_MOD); bf16* XN = (bf16*)(F.ws + WS_XN);
    for (int m = gw; m < M; m += NGW) {
        const float* mod = MOD + (size_t)mod_row(m) * NMOD;
        const f32x4* xr = (const f32x4*)xrow_ptr(A, m) + L_lane; const f32x4* mr = (const f32x4*)(MIX + (size_t)m * DM) + L_lane;
        f32x4 v[4]; float s = 0.f;
#pragma unroll
        for (int j = 0; j < 4; ++j) { v[j] = mr[64 * j]; s += (v[j].x * v[j].x + v[j].y * v[j].y) + (v[j].z * v[j].z + v[j].w * v[j].w); }
        const float rstd = 1.0f / sqrtf(wave_sum(s) * (1.0f / DM) + EPS);
        float s2 = 0.f;
#pragma unroll
        for (int j = 0; j < 4; ++j) { const int c = 4 * L_lane + 256 * j;
            const f32x4 g1 = *(const f32x4*)(mod + 2 * DM + c), wp = *(const f32x4*)(inp(I_NMPOST) + c);
            v[j] = xr[64 * j] + g1 * (v[j] * rstd * wp);
            s2 += (v[j].x * v[j].x + v[j].y * v[j].y) + (v[j].z * v[j].z + v[j].w * v[j].w);
            *(f32x4*)(F.out + (size_t)m * DM + c) = v[j]; }
        const float rstd2 = 1.0f / sqrtf(wave_sum(s2) * (1.0f / DM) + EPS);
        unsigned long long* o8 = (unsigned long long*)(XN + (size_t)m * DM) + L_lane;
#pragma unroll
        for (int j = 0; j < 4; ++j) { const int c = 4 * L_lane + 256 * j;
            const f32x4 sh2 = *(const f32x4*)(mod + 3 * DM + c), sc2 = *(const f32x4*)(mod + 4 * DM + c), wp = *(const f32x4*)(inp(I_NFPRE) + c);
            const f32x4 hh = v[j] * rstd2 * wp * (1.0f + sc2) + sh2;
            o8[64 * j] = (unsigned long long)pk2(hh.x, hh.y) | ((unsigned long long)pk2(hh.z, hh.w) << 32); }
    }
}
__device__ __forceinline__ void p9_rows(Frame& F, const Args& A) {
    const int L_lane = lane_id();
    const int gw = F.vcu * NWAVES + F.wave, NGW = F.G * NWAVES;
    const float* FF = (const float*)(F.ws + WS_F32); const float* MOD = (const float*)(F.ws + WS_MOD);
    for (int m = gw; m < M; m += NGW) {
        const float* mod = MOD + (size_t)mod_row(m) * NMOD;
        const f32x4* fr = (const f32x4*)(FF + (size_t)m * DM) + L_lane;
        f32x4 v[4]; float s = 0.f;
#pragma unroll
        for (int j = 0; j < 4; ++j) { v[j] = fr[64 * j]; s += (v[j].x * v[j].x + v[j].y * v[j].y) + (v[j].z * v[j].z + v[j].w * v[j].w); }
        const float rstd = 1.0f / sqrtf(wave_sum(s) * (1.0f / DM) + EPS);
#pragma unroll
        for (int j = 0; j < 4; ++j) { const int c = 4 * L_lane + 256 * j;
            const f32x4 g2 = *(const f32x4*)(mod + 5 * DM + c), wp = *(const f32x4*)(inp(I_NFPOST) + c);
            float* o = F.out + (size_t)m * DM + c; *(f32x4*)o = *(const f32x4*)o + g2 * (v[j] * rstd * wp); }
    }
}

__global__ void __launch_bounds__(NTHR, 2) fwd_kernel(const Args args) {
    extern __shared__ __attribute__((aligned(16))) unsigned char lds[];
    Frame F;
    F.lds = (LAS unsigned char*)lds;
    F.MISC = (volatile LAS unsigned*)(F.lds + MISC_OFF);
    F.wave = __builtin_amdgcn_readfirstlane(threadIdx.x >> 6);
    F.G = gridDim.x; { const int bx = blockIdx.x; F.vcu = (F.G % 8 == 0) ? (bx % 8) * (F.G / 8) + bx / 8 : bx; }
    F.out = args.out; F.ws = args.ws;
    F.ctl = (gu32*)(F.ws + WS_CTL);
    for (int u = F.wave * 64 + lane_id(); u < (LDS_BYTES - LDSCTL_OFF) / 4; u += NTHR) ((LAS unsigned*)(F.lds + LDSCTL_OFF))[u] = 0u;
    __syncthreads();
    XcdBarrier bar; bar.bar = (unsigned*)(F.ctl + CW_BAR) + args.li * XCD_BAR_WORDS; bar.x = 0; bar.st = nullptr;
    if (N_LAUNCHES == 1) bar = xcd_barrier_post((unsigned*)(F.ctl + CW_BAR) + args.li * XCD_BAR_WORDS, F.MISC + 8, F.wave);
#define GRID_BAR() do { if (N_LAUNCHES == 1) xcd_barrier(bar, F.wave); } while (0)
    const int lo = args.ph_lo, hi = args.ph_hi;
#define IN(k) (lo <= (k) && (k) < hi)
#define BOTH(k) (IN(k) && IN((k) + 1))
    bf16* const XN = (bf16*)(F.ws + WS_XN);
    if (IN(0)) { p0_prologue(F, args); if (BOTH(0)) GRID_BAR(); }
    if (IN(1)) { deferred_transposes(F, 1, F.vcu * NWAVES + F.wave, F.G * NWAVES); __syncthreads(); p1_spectra(F); p1_rows(F, args); if (BOTH(1)) GRID_BAR(); }
    if (IN(2)) {
        pg8::Gemm g{XN, (const bf16*)(F.ws + WS_W1), M, NIN - 3 * HYW, DM, (const bf16*)(F.ws + WS_W1) + (size_t)(NIN - 3 * HYW) * DM, XN}; pg8::DualOrder S; S.init(M, NIN - 3 * HYW, 3 * HYW, M, F.G, (int)blockIdx.x);
        pg8::EpiIn E{(bf16*)(F.ws + WS_Q), (bf16*)(F.ws + WS_K), (bf16*)(F.ws + WS_V), (bf16*)(F.ws + WS_HY), (bf16*)(F.ws + WS_GT),
                     F.out + OUT_NEWK, F.out + OUT_NEWV, inp(I_BGATE), (const float*)(F.ws + WS_ROPE)};
        pg8::gemm_phase<pg8::EpiIn, pg8::DualOrder, true, true>(F.lds + RING_OFF, g, S, E, F.wave);
        if (BOTH(2)) GRID_BAR();
    }
    if (IN(3)) { p3_attention(F); __syncthreads(); p3_hyena(F); if (BOTH(3)) GRID_BAR(); }
    if (IN(4)) {
        pg8::Gemm g{(const bf16*)(F.ws + WS_AH), (const bf16*)(F.ws + WS_W2), M, DM, KMIX}; pg8::StaticOrder S; S.init(M, DM, F.G, (int)blockIdx.x);
        pg8::EpiMerge E{(const bf16*)(F.ws + WS_GT), (bf16*)(F.ws + WS_MG)};
        pg8::gemm_phase<pg8::EpiMerge, pg8::StaticOrder, false, true>(F.lds + RING_OFF, g, S, E, F.wave);
        if ((int)blockIdx.x >= S.nwg && F.G > S.nwg) deferred_transposes(F, 2, ((int)blockIdx.x - S.nwg) * NWAVES + F.wave, (F.G - S.nwg) * NWAVES);
        if (BOTH(4)) GRID_BAR();
    }
    if (IN(5)) {
        pg8::Gemm g{(const bf16*)(F.ws + WS_MG), (const bf16*)(F.ws + WS_W3), M, DM, DM}; pg8::StaticOrder S; S.init(M, DM, F.G, (int)blockIdx.x);
        pg8::EpiF32 E{(float*)(F.ws + WS_F32), DM};
        pg8::gemm_phase<pg8::EpiF32, pg8::StaticOrder, false, true>(F.lds + RING_OFF, g, S, E, F.wave);
        if ((int)blockIdx.x >= S.nwg && F.G > S.nwg) deferred_transposes(F, 3, ((int)blockIdx.x - S.nwg) * NWAVES + F.wave, (F.G - S.nwg) * NWAVES);
        if (BOTH(5)) GRID_BAR();
    }
    if (IN(6)) { p6_rows(F, args); if (BOTH(6)) GRID_BAR(); }
    if (IN(7)) {
        pg8::Gemm g{XN, (const bf16*)(F.ws + WS_W4), M, NUP, DM}; pg8::StaticOrder S; S.init(M, NUP, F.G, (int)blockIdx.x);
        pg8::EpiSwiGLU E{(bf16*)(F.ws + WS_ACT), DFF};
        pg8::gemm_phase<pg8::EpiSwiGLU, pg8::StaticOrder, true, true>(F.lds + RING_OFF, g, S, E, F.wave);
        if (BOTH(7)) GRID_BAR();
    }
    if (IN(8)) {
        pg8::Gemm g{(const bf16*)(F.ws + WS_ACT), (const bf16*)(F.ws + WS_W5), M, DM, DFF}; pg8::StaticOrder S; S.init(M, DM, F.G, (int)blockIdx.x);
        pg8::EpiF32 E{(float*)(F.ws + WS_F32), DM};
        pg8::gemm_phase<pg8::EpiF32, pg8::StaticOrder, false, true>(F.lds + RING_OFF, g, S, E, F.wave);
        if (BOTH(8)) GRID_BAR();
    }
    if (IN(9)) { p9_rows(F, args); }
#undef IN
#undef BOTH
}

extern "C" void kernel_launch(void* const* d_in, const int* in_sizes, int n_in, void* d_out, int out_size, void* d_ws, size_t ws_size, hipStream_t stream) {
    static int grid = 0;
    if (grid == 0) {
        if (n_in != 33 || out_size != M * DM + 2 * M_CTX * KVW || ws_size < WS_END) { fprintf(stderr, "kernel_launch: unexpected sizes n_in %d out %d ws %zu\n", n_in, out_size, ws_size); grid = -1; return; }
        int dev = 0, cus = 0, per_cu = 0;
        if (hipGetDevice(&dev) != hipSuccess || hipDeviceGetAttribute(&cus, hipDeviceAttributeMultiprocessorCount, dev) != hipSuccess) { grid = -1; return; }
        if (hipFuncSetAttribute((const void*)fwd_kernel, hipFuncAttributeMaxDynamicSharedMemorySize, LDS_BYTES) != hipSuccess) { fprintf(stderr, "kernel_launch: hipFuncSetAttribute failed\n"); grid = -1; return; }
        if (hipOccupancyMaxActiveBlocksPerMultiprocessor(&per_cu, (const void*)fwd_kernel, NTHR, LDS_BYTES) != hipSuccess || per_cu < 1) { fprintf(stderr, "kernel_launch: occupancy query says %d\n", per_cu); }
        (void)hipGetLastError();
        grid = cus;
        if (grid != 256) fprintf(stderr, "kernel_launch: %d CUs (expected 256)\n", grid);
    }
    if (grid < 0) return;
    (void)hipMemsetAsync((char*)d_ws + WS_CTL, 0, CTL_ZERO_BYTES, stream);
    Args a{};
    for (int i = 0; i < 33; ++i) a.in[i] = (const float*)d_in[i];
    a.out = (float*)d_out; a.ws = (unsigned char*)d_ws;
    for (int li = 0; li < N_LAUNCHES; ++li) {
        a.ph_lo = (N_LAUNCHES == 1) ? 0 : li; a.ph_hi = (N_LAUNCHES == 1) ? N_PHASES : li + 1; a.li = li;
        hipLaunchKernelGGL(fwd_kernel, dim3(grid), dim3(NTHR), LDS_BYTES, stream, a);
    }
    if (PROBE_PHASE >= 0) { a.ph_lo = PROBE_PHASE; a.ph_hi = PROBE_PHASE + 1; a.li = 1; hipLaunchKernelGGL(fwd_kernel, dim3(grid), dim3(NTHR), LDS_BYTES, stream, a); }
}
```
